# Optimizing an MI355X kernel written in HIP

```python
import jax, jax.numpy as jnp
from jax import lax
import numpy as np

D_MODEL = 1024
BATCH = 2
SEQ = 8192
DEPTH = 4

N_MIXERS = 3
NORM_EPS = 1e-6
D_FF = 4 * D_MODEL
A_CHUNK = 128
A_WIDTH = 2 * D_MODEL
A_GROUP_DIM = 128
A_GROUPS = A_WIDTH // A_GROUP_DIM
B_EXPAND = 128
B_HEADS = D_MODEL // B_EXPAND
B_CHUNK = 64
C_INNER = 2 * D_MODEL
C_HEADS = 4
C_DH = C_INNER // C_HEADS
C_CONV = 4
C_QKV_BLOCK = 4
C_CHUNK = 64

kernel_name = "hybrid_gmlp_hgrn2_mlstm_trunk"


def _rmsnorm(x, g):
    xf = x.astype(jnp.float32)
    y = xf * lax.rsqrt(jnp.mean(xf * xf, axis=-1, keepdims=True) + NORM_EPS)
    return (y * g.astype(jnp.float32)).astype(x.dtype)


def _layernorm(x, g, b=None):
    xf = x.astype(jnp.float32)
    mu = jnp.mean(xf, axis=-1, keepdims=True)
    xc = xf - mu
    y = xc * lax.rsqrt(jnp.mean(xc * xc, axis=-1, keepdims=True) + NORM_EPS) * g.astype(jnp.float32)
    if b is not None:
        y = y + b.astype(jnp.float32)
    return y.astype(x.dtype)


def _to_chunks(t, n_heads, chunk):
    b, s, hd = t.shape
    return t.reshape(b, s // chunk, chunk, n_heads, hd // n_heads).transpose(1, 0, 3, 2, 4)


def _from_chunks(t):
    nc, b, h, l, d = t.shape
    return t.transpose(1, 0, 3, 2, 4).reshape(b, nc * l, h * d)


def _sq_relu_mlp(h, w1, w2):
    return jnp.square(jax.nn.relu(h @ w1)) @ w2


def _gmlp_mixer(h, w_in, ln_g, ln_b, ws, bs, w_out):
    b_, s_, _ = h.shape
    uv = jax.nn.gelu(h @ w_in, approximate=False)
    u, v = jnp.split(uv, 2, axis=-1)
    v = _layernorm(v, ln_g, ln_b)
    v = v.reshape(b_, s_ // A_CHUNK, A_CHUNK, A_GROUPS, A_GROUP_DIM)
    causal = jnp.tril(jnp.ones((A_CHUNK, A_CHUNK), dtype=bool))
    w_causal = jnp.where(causal[None], ws, jnp.zeros((), ws.dtype)).astype(v.dtype)
    mixed = jnp.einsum('gts,bcsgd->bctgd', w_causal, v) + jnp.transpose(bs).astype(v.dtype)[None, None, :, :, None]
    y = u * mixed.reshape(b_, s_, A_WIDTH)
    return y @ w_out


def _hgrn2_mixer(h, w_in, lower_bound, norm_g, w_out):
    b_, s_, _ = h.shape
    q, f, i, g = jnp.split(h @ w_in, 4, axis=-1)
    q = jax.nn.silu(q).astype(jnp.float32)
    i = i.astype(jnp.float32)
    logf = jnp.logaddexp(jnp.log(lower_bound), jnp.log1p(-lower_bound) + jax.nn.log_sigmoid(f.astype(jnp.float32)))
    k = -jnp.expm1(logf)
    qc = _to_chunks(q, B_HEADS, B_CHUNK)
    kc = _to_chunks(k, B_HEADS, B_CHUNK)
    ic = _to_chunks(i, B_HEADS, B_CHUNK)
    lfc = _to_chunks(logf, B_HEADS, B_CHUNK)
    causal = jnp.tril(jnp.ones((B_CHUNK, B_CHUNK), dtype=bool))[:, :, None]

    def step(state, xs):
        qb, kb, ib, lfb = xs
        bcum = jnp.cumsum(lfb, axis=2)
        diff = bcum[:, :, :, None, :] - bcum[:, :, None, :, :]
        decay = jnp.exp(jnp.where(causal, diff, -jnp.inf))
        scores = jnp.einsum('bhtd,bhsd,bhtsd->bhts', qb, kb, decay)
        o = jnp.einsum('bhts,bhsv->bhtv', scores, ib) + jnp.einsum('bhtd,bhdv->bhtv', qb * jnp.exp(bcum), state)
        b_last = bcum[:, :, -1:, :]
        new_state = jnp.exp(b_last[:, :, 0, :])[..., None] * state + jnp.einsum('bhsd,bhsv->bhdv', kb * jnp.exp(b_last - bcum), ib)
        return new_state, o

    state0 = jnp.zeros((b_, B_HEADS, B_EXPAND, D_MODEL // B_HEADS), jnp.float32)
    _, oc = lax.scan(step, state0, (qc, kc, ic, lfc))
    o = _from_chunks(oc).reshape(b_, s_, B_HEADS, D_MODEL // B_HEADS)
    o = _rmsnorm(o, norm_g.reshape(B_HEADS, D_MODEL // B_HEADS)).reshape(b_, s_, D_MODEL)
    o = o * jax.nn.silu(g.astype(jnp.float32))
    return o.astype(h.dtype) @ w_out


def _headwise(t, w):
    b_, s_, c = t.shape
    nb, bsz, _ = w.shape
    return jnp.einsum('bsnd,nde->bsne', t.reshape(b_, s_, nb, bsz), w).reshape(b_, s_, c)


def _mlstm_mixer(h, w_in, conv_w, conv_b, wq, wk, wv, w_gate, b_gate, skip, norm_g, w_out):
    b_, s_, _ = h.shape
    xm, z = jnp.split(h @ w_in, 2, axis=-1)
    conv = lax.conv_general_dilated(
        xm, conv_w.astype(xm.dtype)[:, None, :], window_strides=(1,), padding=[(C_CONV - 1, 0)],
        dimension_numbers=('NWC', 'WIO', 'NWC'), feature_group_count=C_INNER) + conv_b
    ca = jax.nn.silu(conv)
    q = _headwise(ca, wq)
    k = _headwise(ca, wk)
    v = _headwise(xm, wv)
    gates = (jnp.concatenate([q, k, v], axis=-1) @ w_gate + b_gate).astype(jnp.float32)
    logi = gates[..., :C_HEADS]
    logf = jax.nn.log_sigmoid(gates[..., C_HEADS:])
    qc = _to_chunks(q.astype(jnp.float32), C_HEADS, C_CHUNK)
    kc = _to_chunks(k.astype(jnp.float32) * (C_DH ** -0.5), C_HEADS, C_CHUNK)
    vc = _to_chunks(v.astype(jnp.float32), C_HEADS, C_CHUNK)
    lic = _to_chunks(logi, C_HEADS, C_CHUNK)[..., 0]
    lfc = _to_chunks(logf, C_HEADS, C_CHUNK)[..., 0]
    causal = jnp.tril(jnp.ones((C_CHUNK, C_CHUNK), dtype=bool))

    def step(carry, xs):
        c_st, n_st, m_st = carry
        qb, kb, vb, li, lf = xs
        a = jnp.cumsum(lf, axis=-1)
        dmat = jnp.where(causal, a[..., :, None] - a[..., None, :] + li[..., None, :], -jnp.inf)
        inter = a + m_st[..., None]
        m_t = jnp.maximum(jnp.max(dmat, axis=-1), inter)
        w_intra = jnp.exp(dmat - m_t[..., None])
        w_inter = jnp.exp(inter - m_t)
        qk = jnp.einsum('bhtd,bhsd->bhts', qb, kb) * w_intra
        num = jnp.einsum('bhts,bhsv->bhtv', qk, vb) + w_inter[..., None] * jnp.einsum('bhtd,bhdv->bhtv', qb, c_st)
        den = jnp.sum(qk, axis=-1) + w_inter * jnp.einsum('bhtd,bhd->bht', qb, n_st)
        hb = num / jnp.maximum(jnp.abs(den), jnp.exp(-m_t))[..., None]
        a_last = a[..., -1]
        g_s = a_last[..., None] - a + li
        m_new = jnp.maximum(a_last + m_st, jnp.max(g_s, axis=-1))
        w_s = jnp.exp(g_s - m_new[..., None])
        dec = jnp.exp(a_last + m_st - m_new)
        c_new = dec[..., None, None] * c_st + jnp.einsum('bhs,bhsd,bhsv->bhdv', w_s, kb, vb)
        n_new = dec[..., None] * n_st + jnp.einsum('bhs,bhsd->bhd', w_s, kb)
        return (c_new, n_new, m_new), hb

    carry0 = (jnp.zeros((b_, C_HEADS, C_DH, C_DH), jnp.float32),
              jnp.zeros((b_, C_HEADS, C_DH), jnp.float32),
              jnp.full((b_, C_HEADS), -jnp.inf, jnp.float32))
    _, hc = lax.scan(step, carry0, (qc, kc, vc, lic, lfc))
    hh = _from_chunks(hc).reshape(b_, s_, C_HEADS, C_DH)
    hh = _layernorm(hh, norm_g.reshape(C_HEADS, C_DH)).reshape(b_, s_, C_INNER)
    hh = (hh + skip.astype(jnp.float32) * ca.astype(jnp.float32)) * jax.nn.silu(z.astype(jnp.float32))
    return hh.astype(h.dtype) @ w_out


def setup_inputs(seed: int = 0) -> dict:
    key = jax.random.key(seed)
    ks = iter(jax.random.split(key, 40))
    nrm = lambda shape, scale: jax.random.normal(next(ks), shape, jnp.float32) * scale
    kinds = [i % N_MIXERS for i in range(DEPTH)]
    n_a, n_b, n_c = kinds.count(0), kinds.count(1), kinds.count(2)
    nb = C_INNER // C_QKV_BLOCK
    b_gate = jnp.concatenate([
        nrm((n_c, C_HEADS), 0.1),
        jnp.broadcast_to(jnp.linspace(3.0, 6.0, C_HEADS, dtype=jnp.float32), (n_c, C_HEADS)) + nrm((n_c, C_HEADS), 0.02)], axis=-1)
    return {
        "x": nrm((BATCH, SEQ, D_MODEL), 1.0),
        "mix_norm_g": 1.0 + nrm((DEPTH, D_MODEL), 0.02),
        "ffn_norm_g": 1.0 + nrm((DEPTH, D_MODEL), 0.02),
        "final_norm_g": 1.0 + nrm((D_MODEL,), 0.02),
        "ffn_w1": nrm((DEPTH, D_MODEL, D_FF), D_MODEL ** -0.5),
        "ffn_w2": nrm((DEPTH, D_FF, D_MODEL), 0.5 * D_FF ** -0.5),
        "hgrn_lb_logits": nrm((DEPTH, D_MODEL), 0.1),
        "a_w_in": nrm((n_a, D_MODEL, 2 * A_WIDTH), D_MODEL ** -0.5),
        "a_ln_g": 1.0 + nrm((n_a, A_WIDTH), 0.02),
        "a_ln_b": nrm((n_a, A_WIDTH), 0.02),
        "a_ws": nrm((n_a, A_GROUPS, A_CHUNK, A_CHUNK), A_CHUNK ** -0.5),
        "a_bs": 1.0 + nrm((n_a, A_GROUPS, A_CHUNK), 0.02),
        "a_w_out": nrm((n_a, A_WIDTH, D_MODEL), A_WIDTH ** -0.5),
        "b_w_in": nrm((n_b, D_MODEL, 4 * D_MODEL), D_MODEL ** -0.5),
        "b_norm_g": 1.0 + nrm((n_b, D_MODEL), 0.02),
        "b_w_out": nrm((n_b, D_MODEL, D_MODEL), D_MODEL ** -0.5),
        "c_w_in": nrm((n_c, D_MODEL, 2 * C_INNER), D_MODEL ** -0.5),
        "c_conv_w": nrm((n_c, C_CONV, C_INNER), C_CONV ** -0.5),
        "c_conv_b": nrm((n_c, C_INNER), 0.02),
        "c_wq": nrm((n_c, nb, C_QKV_BLOCK, C_QKV_BLOCK), C_QKV_BLOCK ** -0.5),
        "c_wk": nrm((n_c, nb, C_QKV_BLOCK, C_QKV_BLOCK), C_QKV_BLOCK ** -0.5),
        "c_wv": nrm((n_c, nb, C_QKV_BLOCK, C_QKV_BLOCK), C_QKV_BLOCK ** -0.5),
        "c_w_gate": nrm((n_c, 3 * C_INNER, 2 * C_HEADS), 0.5 * (3 * C_INNER) ** -0.5),
        "c_b_gate": b_gate,
        "c_skip": 1.0 + nrm((n_c, C_INNER), 0.02),
        "c_norm_g": 1.0 + nrm((n_c, C_INNER), 0.02),
        "c_w_out": nrm((n_c, C_INNER, D_MODEL), C_INNER ** -0.5),
    }


def reference(x, mix_norm_g, ffn_norm_g, final_norm_g, ffn_w1, ffn_w2, hgrn_lb_logits,
              a_w_in, a_ln_g, a_ln_b, a_ws, a_bs, a_w_out,
              b_w_in, b_norm_g, b_w_out,
              c_w_in, c_conv_w, c_conv_b, c_wq, c_wk, c_wv, c_w_gate, c_b_gate, c_skip, c_norm_g, c_w_out):
    lb_sm = jax.nn.softmax(hgrn_lb_logits.astype(jnp.float32), axis=0)
    lower_bounds = jnp.cumsum(lb_sm, axis=0) - lb_sm[0]
    counts = [0, 0, 0]
    h = x
    for layer in range(DEPTH):
        kind = layer % N_MIXERS
        j = counts[kind]
        counts[kind] += 1
        hn = _rmsnorm(h, mix_norm_g[layer])
        if kind == 0:
            y = _gmlp_mixer(hn, a_w_in[j], a_ln_g[j], a_ln_b[j], a_ws[j], a_bs[j], a_w_out[j])
        elif kind == 1:
            y = _hgrn2_mixer(hn, b_w_in[j], lower_bounds[layer], b_norm_g[j], b_w_out[j])
        else:
            y = _mlstm_mixer(hn, c_w_in[j], c_conv_w[j], c_conv_b[j], c_wq[j], c_wk[j], c_wv[j],
                             c_w_gate[j], c_b_gate[j], c_skip[j], c_norm_g[j], c_w_out[j])
        h = h + y
        h = h + _sq_relu_mlp(_rmsnorm(h, ffn_norm_g[layer]), ffn_w1[layer], ffn_w2[layer])
    return _rmsnorm(h, final_norm_g)
```

```cpp
#include <hip/hip_runtime.h>
#include <hip/hip_cooperative_groups.h>
#include <cstdio>
#include <cstdint>
namespace cg = cooperative_groups;

#define DI __device__ __forceinline__
#define LAS __attribute__((address_space(3)))
typedef unsigned short bf16_t;
typedef short bf16x8 __attribute__((ext_vector_type(8)));
typedef short s16x4 __attribute__((ext_vector_type(4)));
typedef float f32x4 __attribute__((ext_vector_type(4)));
typedef float f32x2 __attribute__((ext_vector_type(2)));
typedef unsigned u32x4 __attribute__((ext_vector_type(4)));
typedef unsigned u32x2 __attribute__((ext_vector_type(2)));

constexpr int T = 16384, DM = 1024, SEQ = 8192;
constexpr int NTHR = 512;
constexpr int LDS_BYTES = 157696;
constexpr int LDS_BARST = 157680;

constexpr size_t MB = 1024 * 1024;
constexpr size_t WS_WIN = 0;
constexpr size_t WS_WOUT = 8 * MB;
constexpr size_t WS_W1 = 12 * MB;
constexpr size_t WS_W2 = 20 * MB;
constexpr size_t WS_MISC = 28 * MB;
constexpr size_t WS_GATES = WS_MISC;
constexpr size_t WS_SCAL = WS_MISC + 512 * 1024;
constexpr size_t WS_DEC = WS_MISC;
constexpr size_t WS_STATS = WS_MISC;
constexpr size_t WS_SSQA = WS_MISC + 1536 * 1024;
constexpr size_t WS_SSQB = WS_MISC + 2560 * 1024;
constexpr size_t WS_BAR = WS_MISC + 3584 * 1024;
constexpr size_t WS_HN = 32 * MB;
constexpr size_t WS_BIG = 64 * MB;
constexpr size_t WS_CA = 192 * MB;
constexpr size_t WS_END = 256 * MB;

DI float bf2f(unsigned b) { return __uint_as_float(b << 16); }
typedef __bf16 nbf16x2 __attribute__((ext_vector_type(2)));
DI unsigned pack2(float lo, float hi) { nbf16x2 v; v.x = (__bf16)lo; v.y = (__bf16)hi; return __builtin_bit_cast(unsigned, v); }
DI unsigned f2bf(float f) { return pack2(f, 0.f) & 0xFFFFu; }
DI float lo_f(unsigned w) { return __uint_as_float(w << 16); }
DI float hi_f(unsigned w) { return __uint_as_float(w & 0xFFFF0000u); }
DI float sigmoidf_(float x) { return 1.0f / (1.0f + __expf(-x)); }
DI float siluf_(float x) { return x / (1.0f + __expf(-x)); }
DI float wave_sum(float v) {
#pragma unroll
    for (int o = 32; o >= 1; o >>= 1) v += __shfl_xor(v, o, 64);
    return v;
}
DI float wave_max(float v) {
#pragma unroll
    for (int o = 32; o >= 1; o >>= 1) v = fmaxf(v, __shfl_xor(v, o, 64));
    return v;
}
DI bf16x8 tr_frag(unsigned a0, unsigned a1) {
    s16x4 r0, r1;
    asm volatile("ds_read_b64_tr_b16 %0, %2\n\tds_read_b64_tr_b16 %1, %3\n\ts_waitcnt lgkmcnt(0)" : "=&v"(r0), "=&v"(r1) : "v"(a0), "v"(a1) : "memory");
    bf16x8 r; r[0] = r0[0]; r[1] = r0[1]; r[2] = r0[2]; r[3] = r0[3]; r[4] = r1[0]; r[5] = r1[1]; r[6] = r1[2]; r[7] = r1[3];
    return r;
}
DI unsigned tr_addr(unsigned base, int pitch, int k0, int n0, int lane) {
    const int g = lane >> 4, q = (lane & 15) >> 2, p = lane & 3;
    return base + (unsigned)((k0 + 8 * g + q) * pitch + (n0 + 4 * p) * 2);
}
DI bf16x8 tr_load(unsigned base, int pitch, int k0, int n0, int lane) { const unsigned a = tr_addr(base, pitch, k0, n0, lane); return tr_frag(a, a + 4 * pitch); }
DI void tr_load4(bf16x8 (&o)[4], unsigned a0, unsigned a1, unsigned a2, unsigned a3, int pitch) {
    s16x4 r0, r1, r2, r3, r4, r5, r6, r7;
    const unsigned b0 = a0 + 4 * pitch, b1 = a1 + 4 * pitch, b2 = a2 + 4 * pitch, b3 = a3 + 4 * pitch;
    asm volatile("ds_read_b64_tr_b16 %0, %8\n\tds_read_b64_tr_b16 %1, %9\n\tds_read_b64_tr_b16 %2, %10\n\tds_read_b64_tr_b16 %3, %11\n\t"
                 "ds_read_b64_tr_b16 %4, %12\n\tds_read_b64_tr_b16 %5, %13\n\tds_read_b64_tr_b16 %6, %14\n\tds_read_b64_tr_b16 %7, %15\n\ts_waitcnt lgkmcnt(0)"
                 : "=&v"(r0), "=&v"(r1), "=&v"(r2), "=&v"(r3), "=&v"(r4), "=&v"(r5), "=&v"(r6), "=&v"(r7)
                 : "v"(a0), "v"(b0), "v"(a1), "v"(b1), "v"(a2), "v"(b2), "v"(a3), "v"(b3) : "memory");
    o[0] = (bf16x8){r0[0], r0[1], r0[2], r0[3], r1[0], r1[1], r1[2], r1[3]};
    o[1] = (bf16x8){r2[0], r2[1], r2[2], r2[3], r3[0], r3[1], r3[2], r3[3]};
    o[2] = (bf16x8){r4[0], r4[1], r4[2], r4[3], r5[0], r5[1], r5[2], r5[3]};
    o[3] = (bf16x8){r6[0], r6[1], r6[2], r6[3], r7[0], r7[1], r7[2], r7[3]};
}
DI bf16x8 row_load(LAS unsigned char* lds, unsigned base, int pitch, int r0, int k0, int lane) {
    return *(const LAS bf16x8*)(lds + base + (unsigned)((r0 + (lane & 15)) * pitch + (k0 + 8 * (lane >> 4)) * 2));
}
#define LDS_BAR() do { asm volatile("s_waitcnt lgkmcnt(0)" ::: "memory"); __builtin_amdgcn_s_barrier(); asm volatile("" ::: "memory"); } while (0)
DI f32x4 mfma16(bf16x8 a, bf16x8 b, f32x4 c) { return __builtin_amdgcn_mfma_f32_16x16x32_bf16(a, b, c, 0, 0, 0); }

namespace pg8 {
constexpr int BM = 256, BK = 64, HALF = 128, HTB = HALF * BK * 2, STAGE_BYTES = 8 * HTB, NXCD = 8, WGM = 8;
DI int lds_byte(int r, int c) { const int st = (r >> 4) * 2 + (c >> 5), rr = r & 15, cc = c & 31, ob = rr * 64 + cc * 2; return st * 1024 + (ob ^ (((ob >> 9) & 1) << 5)); }
DI void stage_rc(int b, int& R, int& C) { const int st = b / 1024, sb = b % 1024, swz = sb ^ (((sb >> 9) & 1) << 5); R = (st >> 1) * 16 + swz / 64; C = (st & 1) * 32 + (swz % 64) / 2; }
DI int perm32(int rho) { const int n = rho >> 4, i = rho & 15; return 8 * (i >> 2) + 4 * n + (i & 3); }
struct Unit { int pm, pn; };
struct Gemm { const bf16_t* A; const bf16_t* Bt; int M, N, K, lda; };
struct StaticOrder {
    int nM, nN, nwg, G, c;
    DI void init(int M, int N, int G_, int c_) { nM = M / BM; nN = N / BM; nwg = nM * nN; G = G_; c = c_; }
    DI bool next(int i, Unit& u) const {
        const long L = (long)i * G + c; if (L >= nwg) return false;
        int wgid = (int)L; { const int q = nwg / NXCD, r = nwg % NXCD, xcd = wgid % NXCD, off = wgid / NXCD; wgid = (xcd < r ? xcd * (q + 1) : r * (q + 1) + (xcd - r) * q) + off; }
        const int nig = WGM * nN, gid = wgid / nig, fm = gid * WGM, gsz = (nM - fm) < WGM ? (nM - fm) : WGM;
        u.pm = fm + ((wgid % nig) % gsz); u.pn = (wgid % nig) / gsz; return true;
    }
};
DI unsigned cvt_pk_bf16(float lo, float hi) { unsigned r; asm volatile("v_cvt_pk_bf16_f32 %0, %1, %2" : "=v"(r) : "v"(lo), "v"(hi)); return r; }
DI f32x2 gelu_pk(f32x2 v) {
    const f32x2 av = __builtin_elementwise_abs(v), d = av * 0.2316418882f + 1.0f;
    f32x2 t; t.x = __builtin_amdgcn_rcpf(d.x); t.y = __builtin_amdgcn_rcpf(d.y);
    f32x2 q = t * 0.5307027145f + (-0.7265760135f); q = q * t + 0.7107068705f; q = q * t + (-0.142248368f); q = q * t + 0.127414796f; q = q * t;
    const f32x2 s = (v * v) * (-0.72134752044f);
    f32x2 e; e.x = __builtin_amdgcn_exp2f(s.x); e.y = __builtin_amdgcn_exp2f(s.y);
    const f32x2 m = v * (q * e), r = v - m;
    f32x2 o; o.x = v.x < 0.f ? m.x : r.x; o.y = v.y < 0.f ? m.y : r.y; return o;
}
struct EpiAny {
    int mode; bf16_t* O; bf16_t* HB; const LAS float* rstd_tab; float* ssq_out; float* vstat;
    DI bool perm() const { return true; }
    DI void operator()(const f32x4 (&acc)[2][2][4][2], const Unit& u, int wr, int wc, int fr, int fq, int ui) const {
        if (mode == 3) {
            const int row0 = u.pm * BM + wr * 64 + fr, col0 = u.pn * BM + wc * 32 + 8 * fq;
#pragma unroll
            for (int ai = 0; ai < 2; ++ai) {
                u32x4 oldv[4][2];
#pragma unroll
                for (int m = 0; m < 4; ++m)
#pragma unroll
                    for (int bj = 0; bj < 2; ++bj) oldv[m][bj] = *(const u32x4*)(HB + (size_t)(row0 + ai * HALF + m * 16) * 1024 + col0 + bj * HALF);
#pragma unroll
                for (int m = 0; m < 4; ++m) { const int row = row0 + ai * HALF + m * 16; bf16_t* hb = HB + (size_t)row * 1024 + col0;
                    float ss = 0.f;
#pragma unroll
                    for (int bj = 0; bj < 2; ++bj) { const u32x4 old = oldv[m][bj];
                        const f32x4 a0 = acc[ai][bj][m][0], a1 = acc[ai][bj][m][1];
                        u32x4 w; w.x = cvt_pk_bf16(lo_f(old.x) + a0[0], hi_f(old.x) + a0[1]); w.y = cvt_pk_bf16(lo_f(old.y) + a0[2], hi_f(old.y) + a0[3]);
                        w.z = cvt_pk_bf16(lo_f(old.z) + a1[0], hi_f(old.z) + a1[1]); w.w = cvt_pk_bf16(lo_f(old.w) + a1[2], hi_f(old.w) + a1[3]);
                        *(u32x4*)(hb + bj * HALF) = w;
                        const float r0 = lo_f(w.x), r1 = hi_f(w.x), r2 = lo_f(w.y), r3 = hi_f(w.y), r4 = lo_f(w.z), r5 = hi_f(w.z), r6 = lo_f(w.w), r7 = hi_f(w.w);
                        ss += (r0 * r0 + r1 * r1) + (r2 * r2 + r3 * r3) + (r4 * r4 + r5 * r5) + (r6 * r6 + r7 * r7); }
                    ss += __shfl_xor(ss, 16, 64); ss += __shfl_xor(ss, 32, 64);
                    if (fq == 0) ssq_out[row * 16 + u.pn * 4 + wc] = ss; }
            }
        } else {
            const int row0 = u.pm * BM + wr * 64 + fr, col0 = u.pn * BM + wc * 32 + 8 * fq;
#pragma unroll
            for (int ai = 0; ai < 2; ++ai)
#pragma unroll
                for (int m = 0; m < 4; ++m) { const int row = row0 + ai * HALF + m * 16; bf16_t* rowp = O + (size_t)row * 4096 + col0;
                    const float rs = rstd_tab[(ui & 3) * 256 + wr * 64 + fr + ai * HALF + m * 16];
                    float st1 = 0.f, st2 = 0.f;
#pragma unroll
                    for (int bj = 0; bj < 2; ++bj) { f32x4 v0 = acc[ai][bj][m][0] * rs, v1 = acc[ai][bj][m][1] * rs;
                        if (mode == 1) { f32x2 a = gelu_pk((f32x2){v0[0], v0[1]}), b = gelu_pk((f32x2){v0[2], v0[3]}), c = gelu_pk((f32x2){v1[0], v1[1]}), d = gelu_pk((f32x2){v1[2], v1[3]});
                            v0 = (f32x4){a.x, a.y, b.x, b.y}; v1 = (f32x4){c.x, c.y, d.x, d.y}; }
                        else if (mode == 2) {
#pragma unroll
                            for (int j = 0; j < 4; ++j) { const float a = fmaxf(v0[j], 0.f), b = fmaxf(v1[j], 0.f); v0[j] = a * a; v1[j] = b * b; } }
                        u32x4 w; w.x = cvt_pk_bf16(v0[0], v0[1]); w.y = cvt_pk_bf16(v0[2], v0[3]); w.z = cvt_pk_bf16(v1[0], v1[1]); w.w = cvt_pk_bf16(v1[2], v1[3]);
                        *(u32x4*)(rowp + bj * HALF) = w;
                        if (mode == 1 && u.pn >= 8) {
                            const float r0 = lo_f(w.x), r1 = hi_f(w.x), r2 = lo_f(w.y), r3 = hi_f(w.y), r4 = lo_f(w.z), r5 = hi_f(w.z), r6 = lo_f(w.w), r7 = hi_f(w.w);
                            st1 += (r0 + r1) + (r2 + r3) + (r4 + r5) + (r6 + r7);
                            st2 += (r0 * r0 + r1 * r1) + (r2 * r2 + r3 * r3) + (r4 * r4 + r5 * r5) + (r6 * r6 + r7 * r7); } }
                    if (mode == 1 && u.pn >= 8) {
                        st1 += __shfl_xor(st1, 16, 64); st1 += __shfl_xor(st1, 32, 64); st2 += __shfl_xor(st2, 16, 64); st2 += __shfl_xor(st2, 32, 64);
                        if (fq == 0) *(f32x2*)(vstat + ((size_t)row * 32 + (u.pn - 8) * 4 + wc) * 2) = (f32x2){st1, st2}; } }
        }
    }
};

template <class Epi, class Sched>
DI void gemm_phase(LAS unsigned char* lds, const Gemm g, const Sched& S, const Epi& E, const int tid) {
    const int wid = __builtin_amdgcn_readfirstlane(tid >> 6), lane = tid & 63, wr = wid >> 2, wc = wid & 3, fr = lane & 15, fq = lane >> 4;
    const int K = g.K, nt = K / BK;
    unsigned voffA[2], voffB[2];
#pragma unroll
    for (int i = 0; i < 2; ++i) { int R, C; stage_rc(tid * 16 + i * 8192, R, C); const int Rb = E.perm() ? ((R & ~31) + perm32(R & 31)) : R;
        voffA[i] = (unsigned)(R * g.lda + C) * 2u; voffB[i] = (unsigned)(Rb * K + C) * 2u; }
    const size_t kstep = (size_t)(BK * 2);
    const size_t hstepA = (size_t)HALF * g.lda * 2, hstepB = (size_t)HALF * K * 2;
    const size_t tstepA = 2 * hstepA, tstepB = 2 * hstepB;
    const unsigned ldsw = (unsigned)wid * 1024u;
    const int aoff = lds_byte(wr * 64 + fr, fq * 8), boff = lds_byte(wc * 32 + fr, fq * 8);
#define PG8_SA(b, h) (((b) * 2 + (h)) * HTB)
#define PG8_SB(b, h) ((4 + (b) * 2 + (h)) * HTB)
#define PG8_STAGE(bufoff, gbase, voff) do { _Pragma("unroll") for (int _i = 0; _i < 2; ++_i) \
        __builtin_amdgcn_global_load_lds((const unsigned*)((const char*)(gbase) + (voff)[_i]), (LAS unsigned*)(lds + (bufoff) + ldsw + _i * 8192), 16, 0, 0); } while (0)
#define PG8_LDA(dst, b, h) do { _Pragma("unroll") for (int m = 0; m < 4; ++m) _Pragma("unroll") for (int k = 0; k < 2; ++k) dst[m][k] = *(const LAS bf16x8*)(lds + PG8_SA(b, h) + aoff + m * 2048 + k * 1024); } while (0)
#define PG8_LDB(dst, b, h) do { _Pragma("unroll") for (int n = 0; n < 2; ++n) _Pragma("unroll") for (int k = 0; k < 2; ++k) dst[n][k] = *(const LAS bf16x8*)(lds + PG8_SB(b, h) + boff + n * 2048 + k * 1024); } while (0)
#define PG8_MMA(ai, bj, At, Bt) do { __builtin_amdgcn_s_setprio(1); _Pragma("unroll") for (int m = 0; m < 4; ++m) _Pragma("unroll") for (int n = 0; n < 2; ++n) _Pragma("unroll") for (int k = 0; k < 2; ++k) \
        acc[ai][bj][m][n] = __builtin_amdgcn_mfma_f32_16x16x32_bf16(Bt[n][k], At[m][k], acc[ai][bj][m][n], 0, 0, 0); __builtin_amdgcn_s_setprio(0); } while (0)
#define PG8_WAIT_V(n) asm volatile("s_waitcnt vmcnt(" #n ")" ::: "memory")
#define PG8_WAIT_L(n) asm volatile("s_waitcnt lgkmcnt(" #n ")" ::: "memory")
#define PG8_BAR __builtin_amdgcn_s_barrier()
#define PG8_SCHED __builtin_amdgcn_sched_barrier(0)
    Unit cur, nxt; int ui = 0;
    if (!S.next(0, cur)) return;
    f32x4 acc[2][2][4][2];
#pragma unroll
    for (int a = 0; a < 2; ++a)
#pragma unroll
        for (int b = 0; b < 2; ++b)
#pragma unroll
            for (int m = 0; m < 4; ++m)
#pragma unroll
                for (int n = 0; n < 2; ++n) acc[a][b][m][n] = (f32x4){0.f, 0.f, 0.f, 0.f};
    bf16x8 At[4][2], B0[2][2], B1[2][2];
    const char* cA = (const char*)g.A + (size_t)cur.pm * tstepA; const char* cB = (const char*)g.Bt + (size_t)cur.pn * tstepB;
    PG8_STAGE(PG8_SB(0, 0), cB, voffB); PG8_STAGE(PG8_SA(0, 0), cA, voffA); PG8_STAGE(PG8_SB(0, 1), cB + hstepB, voffB); PG8_STAGE(PG8_SA(0, 1), cA + hstepA, voffA);
    if (wr == 1) PG8_BAR;
    PG8_WAIT_V(4); PG8_BAR;
    PG8_STAGE(PG8_SB(1, 0), cB + kstep, voffB); PG8_STAGE(PG8_SA(1, 0), cA + kstep, voffA); PG8_STAGE(PG8_SB(1, 1), cB + hstepB + kstep, voffB);
    PG8_WAIT_V(6); PG8_BAR;
    for (;;) {
        const bool has_next = S.next(ui + 1, nxt);
        const char* nA = has_next ? (const char*)g.A + (size_t)nxt.pm * tstepA : cA; const char* nB = has_next ? (const char*)g.Bt + (size_t)nxt.pn * tstepB : cB;
        for (int t = 0; t < nt; t += 2) {
            const bool last = (t == nt - 2);
            const char* a1 = cA + (size_t)(t + 1) * kstep;
            const char* a2 = last ? nA : cA + (size_t)(t + 2) * kstep; const char* b2 = last ? nB : cB + (size_t)(t + 2) * kstep;
            const char* a3 = a2 + kstep; const char* b3 = b2 + kstep;
            PG8_LDB(B0, 0, 0); PG8_SCHED; PG8_LDA(At, 0, 0); PG8_STAGE(PG8_SA(1, 1), a1 + hstepA, voffA);
            PG8_WAIT_L(8); PG8_BAR; PG8_WAIT_L(0); PG8_MMA(0, 0, At, B0); PG8_BAR; PG8_SCHED;
            PG8_LDB(B1, 0, 1); PG8_STAGE(PG8_SB(0, 0), b2, voffB);
            PG8_BAR; PG8_WAIT_L(0); PG8_MMA(0, 1, At, B1); PG8_BAR;
            PG8_LDA(At, 0, 1); PG8_STAGE(PG8_SA(0, 0), a2, voffA);
            PG8_BAR; PG8_WAIT_L(0); PG8_MMA(1, 0, At, B0); PG8_BAR; PG8_SCHED;
            PG8_STAGE(PG8_SB(0, 1), b2 + hstepB, voffB);
            PG8_WAIT_V(6); PG8_BAR; PG8_MMA(1, 1, At, B1); PG8_BAR;
            PG8_LDB(B0, 1, 0); PG8_SCHED; PG8_LDA(At, 1, 0); PG8_STAGE(PG8_SA(0, 1), a2 + hstepA, voffA);
            PG8_WAIT_L(8); PG8_BAR; PG8_WAIT_L(0); PG8_MMA(0, 0, At, B0); PG8_BAR; PG8_SCHED;
            PG8_LDB(B1, 1, 1); PG8_STAGE(PG8_SB(1, 0), b3, voffB);
            PG8_BAR; PG8_WAIT_L(0); PG8_MMA(0, 1, At, B1); PG8_BAR;
            PG8_LDA(At, 1, 1); PG8_STAGE(PG8_SA(1, 0), a3, voffA);
            PG8_BAR; PG8_WAIT_L(0); PG8_MMA(1, 0, At, B0); PG8_BAR; PG8_SCHED;
            PG8_STAGE(PG8_SB(1, 1), b3 + hstepB, voffB);
            PG8_WAIT_V(6); PG8_BAR; PG8_MMA(1, 1, At, B1); PG8_BAR;
        }
        E(acc, cur, wr, wc, fr, fq, ui);
        if (!has_next) break;
#pragma unroll
        for (int a = 0; a < 2; ++a)
#pragma unroll
            for (int b = 0; b < 2; ++b)
#pragma unroll
                for (int m = 0; m < 4; ++m)
#pragma unroll
                    for (int n = 0; n < 2; ++n) acc[a][b][m][n] = (f32x4){0.f, 0.f, 0.f, 0.f};
        cur = nxt; cA = nA; cB = nB; ++ui;
    }
    PG8_WAIT_V(0);
    if (wr == 0) PG8_BAR;
    PG8_BAR;
#undef PG8_SA
#undef PG8_SB
#undef PG8_STAGE
#undef PG8_LDA
#undef PG8_LDB
#undef PG8_MMA
#undef PG8_WAIT_V
#undef PG8_WAIT_L
#undef PG8_BAR
#undef PG8_SCHED
}
}

#define XB_TMO      128
#define XB_XCNT(j)  (256  + 64 * (j))
#define XB_XSUB(j)  (1280 + 64 * (j))
#define XB_XGEN(j)  (2304 + 64 * (j))
#define XB_TOP      3328
#define XB_TOPGEN   3392
#define XCD_BAR_WORDS 3456
#define XB_SPIN_CAP (1u << 18)
DI unsigned xb_ld(unsigned* p)              { return __hip_atomic_load(p, __ATOMIC_RELAXED, __HIP_MEMORY_SCOPE_AGENT); }
DI unsigned xb_add(unsigned* p, unsigned v) { return __hip_atomic_fetch_add(p, v, __ATOMIC_RELAXED, __HIP_MEMORY_SCOPE_AGENT); }
DI unsigned xb_xcc_id() { return (unsigned)__builtin_amdgcn_s_getreg((3 << 11) | 20) & 0xFu; }
#define XB_SPIN(cond, bar) do { unsigned _sp = 0; while (cond) { __builtin_amdgcn_s_sleep(1); \
    if ((++_sp & 255u) == 0u) { if (xb_ld(&(bar)[XB_TMO])) break; if (_sp > XB_SPIN_CAP) { atomicAdd(&(bar)[XB_TMO], 1u); break; } } } } while (0)
struct XcdBarrier { unsigned* bar; unsigned x; volatile LAS unsigned* st; };
DI XcdBarrier xcd_barrier_post(unsigned* bar, volatile LAS unsigned* st) {
    XcdBarrier b; b.bar = bar; b.x = xb_xcc_id(); b.st = st;
    if (threadIdx.x == 0) st[2] = xb_add(&bar[XB_XCNT(b.x)], 1u);
    return b;
}
DI void xcd_barrier_complete(unsigned* bar, unsigned x, unsigned& nloc, unsigned& nx) {
    const unsigned G = gridDim.x * gridDim.y * gridDim.z;
    unsigned sum, cnt, mine, sp = 0u;
    for (;;) {
        sum = 0u; cnt = 0u; mine = 0u;
#pragma unroll
        for (unsigned j = 0; j < 16; ++j) { const unsigned c = xb_ld(&bar[XB_XCNT(j)]); sum += c; cnt += (c > 0u) ? 1u : 0u; mine = (j == x) ? c : mine; }
        if (sum == G) break;
        __builtin_amdgcn_s_sleep(1);
        if ((++sp & 255u) == 0u) { if (xb_ld(&bar[XB_TMO])) break; if (sp > XB_SPIN_CAP) { atomicAdd(&bar[XB_TMO], 1u); break; } }
    }
    nloc = mine > 0u ? mine : 1u; nx = cnt > 0u ? cnt : 1u;
}
DI void xcd_barrier_census_wave0(const XcdBarrier& b) {
    const unsigned lane = threadIdx.x & 63u, G = gridDim.x * gridDim.y * gridDim.z;
    unsigned cnt, sum, sp = 0u;
    for (;;) {
        cnt = (lane < 16u) ? xb_ld(&b.bar[XB_XCNT(lane)]) : 0u;
        sum = cnt;
#pragma unroll
        for (int o = 32; o >= 1; o >>= 1) sum += __shfl_xor(sum, o, 64);
        if (sum == G) break;
        __builtin_amdgcn_s_sleep(1);
        if ((++sp & 255u) == 0u) { if (xb_ld(&b.bar[XB_TMO])) break; if (sp > XB_SPIN_CAP) { if (lane == 0u) atomicAdd(&b.bar[XB_TMO], 1u); break; } }
    }
    const unsigned nx = (unsigned)__popcll(__ballot(cnt > 0u)), mine = __shfl(cnt, (int)b.x, 64);
    if (lane == 0u) { b.st[0] = mine > 0u ? mine : 1u; b.st[1] = nx > 0u ? nx : 1u; }
}
DI void xcd_barrier(const XcdBarrier& b) {
    asm volatile("s_waitcnt vmcnt(0)" ::: "memory");
    __syncthreads();
    if (threadIdx.x < 64 && b.st[0] == 0u) xcd_barrier_census_wave0(b);
    if (threadIdx.x == 0) {
        unsigned* bar = b.bar;
        __builtin_amdgcn_s_waitcnt(0);
        unsigned nloc = b.st[0], nx = b.st[1];
        if (nloc == 0u) { xcd_barrier_complete(bar, b.x, nloc, nx); b.st[0] = nloc; b.st[1] = nx; }
        const unsigned old = xb_add(&bar[XB_XSUB(b.x)], 1u);
        const unsigned gen = old / nloc;
        if (old + 1u == (gen + 1u) * nloc) {
            __builtin_amdgcn_fence(__ATOMIC_RELEASE, "agent");
            asm volatile("s_waitcnt vmcnt(0)" ::: "memory");
            const unsigned og = xb_add(&bar[XB_TOP], 1u);
            const unsigned tg = og / nx;
            if (og + 1u == (tg + 1u) * nx) xb_add(&bar[XB_TOPGEN], 1u);
            else XB_SPIN(xb_ld(&bar[XB_TOPGEN]) == tg, bar);
            __builtin_amdgcn_fence(__ATOMIC_ACQUIRE, "agent");
            xb_add(&bar[XB_XGEN(b.x)], 1u);
            asm volatile("s_waitcnt vmcnt(0)" ::: "memory");
        } else {
            XB_SPIN(xb_ld(&bar[XB_XGEN(b.x)]) == gen, bar);
            __builtin_amdgcn_fence(__ATOMIC_ACQUIRE, "agent");
            asm volatile("s_waitcnt vmcnt(0)" ::: "memory");
        }
    }
    __syncthreads();
}

struct Args {
    const float* in[27];
    float* out;
    unsigned char* ws;
    int use_cg, pad;
};
struct Ctx {
    LAS unsigned char* lds; unsigned ldsb;
    int tid, lane, wave, bid, nb;
};

DI Ctx mk(const Ctx& c0) {
    Ctx c = c0; int t = threadIdx.x; asm volatile("" : "+v"(t)); int b = c0.bid, n = c0.nb; asm volatile("" : "+s"(b), "+s"(n));
    c.tid = t; c.lane = t & 63; c.wave = __builtin_amdgcn_readfirstlane(t >> 6); c.bid = b; c.nb = n; return c;
}
DI void run_gemm(const Ctx& c0, const bf16_t* A, int lda, const bf16_t* Bt, int N, int K, int mode, bf16_t* O, bf16_t* HB, const float* ssq_in, float* ssq_out, float* vstat) {
    const Ctx c = mk(c0);
    pg8::Gemm g{A, Bt, T, N, K, lda};
    pg8::StaticOrder S; S.init(T, N, c.nb, c.bid);
    LAS float* tab = (LAS float*)(c.lds + pg8::STAGE_BYTES);
    if (mode != 3) {
        pg8::Unit u;
        if (S.next(c.tid >> 7, u)) {
#pragma unroll
            for (int k = 0; k < 2; ++k) { const int r = (c.tid & 127) + 128 * k; const f32x4* sp = (const f32x4*)(ssq_in + (size_t)(u.pm * 256 + r) * 16);
                const f32x4 s4 = (sp[0] + sp[1]) + (sp[2] + sp[3]);
                tab[(c.tid >> 7) * 256 + r] = rsqrtf((s4[0] + s4[1] + s4[2] + s4[3]) * (1.0f / 1024.f) + 1e-6f); }
        }
        __syncthreads();
    }
    pg8::gemm_phase<pg8::EpiAny, pg8::StaticOrder>(c.lds, g, S, pg8::EpiAny{mode, O, HB, tab, ssq_out, vstat}, c.tid);
    __syncthreads();
}

DI void convert_wT(const Ctx& c0, const float* __restrict__ W, bf16_t* __restrict__ Wt, int K, int N, const float* __restrict__ gain) {
    const Ctx c = mk(c0);
    LAS float* tile = (LAS float*)c.lds;
    const int tn = N / 64, ntile = (K / 64) * tn;
    const int r0 = c.tid >> 4, c4 = (c.tid & 15) * 4;
    float4 v[2]; float gk[2] = {1.f, 1.f};
#define CV_LOAD(IT) do { const int k0_ = ((IT) / tn) * 64, n0_ = ((IT) % tn) * 64; \
        _Pragma("unroll") for (int p = 0; p < 2; ++p) { v[p] = *(const float4*)(W + (size_t)(k0_ + r0 + 32 * p) * N + n0_ + c4); gk[p] = gain ? gain[k0_ + r0 + 32 * p] : 1.f; } } while (0)
    if (c.bid < ntile) CV_LOAD(c.bid);
    for (int it = c.bid; it < ntile; it += c.nb) {
        const int k0 = (it / tn) * 64, n0 = (it % tn) * 64;
#pragma unroll
        for (int p = 0; p < 2; ++p) {
            const int r = r0 + 32 * p;
            tile[r * 65 + c4 + 0] = v[p].x * gk[p]; tile[r * 65 + c4 + 1] = v[p].y * gk[p]; tile[r * 65 + c4 + 2] = v[p].z * gk[p]; tile[r * 65 + c4 + 3] = v[p].w * gk[p];
        }
        if (it + c.nb < ntile) CV_LOAD(it + c.nb);
        LDS_BAR();
        const int n = c.tid >> 3, kg = c.tid & 7;
        u32x4 w;
        w.x = pack2(tile[(kg * 8 + 0) * 65 + n], tile[(kg * 8 + 1) * 65 + n]);
        w.y = pack2(tile[(kg * 8 + 2) * 65 + n], tile[(kg * 8 + 3) * 65 + n]);
        w.z = pack2(tile[(kg * 8 + 4) * 65 + n], tile[(kg * 8 + 5) * 65 + n]);
        w.w = pack2(tile[(kg * 8 + 6) * 65 + n], tile[(kg * 8 + 7) * 65 + n]);
        *(u32x4*)(Wt + (size_t)(n0 + n) * K + k0 + kg * 8) = w;
        LDS_BAR();
    }
#undef CV_LOAD
    __syncthreads();
}

DI void prologue_phase(const Ctx& c0, const float* src, bf16_t* dst, float* ssqA) {
    const Ctx c = mk(c0);
    for (int rowb = c.bid * 8 + c.wave; rowb < T; rowb += 2 * c.nb * 8) {
        float4 v[2][4];
#pragma unroll
        for (int k = 0; k < 2; ++k) { const int row = rowb + k * c.nb * 8; if (row < T) {
#pragma unroll
            for (int i = 0; i < 4; ++i) v[k][i] = ((const float4*)(src + (size_t)row * DM))[c.lane + 64 * i]; } }
#pragma unroll
        for (int k = 0; k < 2; ++k) { const int row = rowb + k * c.nb * 8; if (row < T) {
            float ss = 0.f;
#pragma unroll
            for (int i = 0; i < 4; ++i) {
                u32x2 w; w.x = pack2(v[k][i].x, v[k][i].y); w.y = pack2(v[k][i].z, v[k][i].w);
                *(u32x2*)(dst + (size_t)row * DM + (c.lane + 64 * i) * 4) = w;
                const float r0 = lo_f(w.x), r1 = hi_f(w.x), r2 = lo_f(w.y), r3 = hi_f(w.y);
                ss += r0 * r0 + r1 * r1 + r2 * r2 + r3 * r3;
            }
            ss = wave_sum(ss);
            if (c.lane < 16) ssqA[row * 16 + c.lane] = (c.lane == 0) ? ss : 0.f; } }
    }
}
DI void final_norm_phase(const Ctx& c0, const bf16_t* hb, float* out, const float* __restrict__ g, const float* ssq) {
    const Ctx c = mk(c0);
    constexpr int NCH = T * DM / 8, STRIDE = 256 * NTHR;
    for (int i0 = c.bid * NTHR + c.tid; i0 < NCH; i0 += 4 * c.nb * NTHR) {
        const int gi = ((c.bid * NTHR + c.tid) & 127) * 2;
        const float4 g0 = ((const float4*)g)[gi], g1 = ((const float4*)g)[gi + 1];
        u32x4 w[4]; f32x4 sa[4], sb[4], sc[4], sd[4];
#pragma unroll
        for (int k = 0; k < 4; ++k) { const int i = i0 + k * c.nb * NTHR; if (i < NCH) { w[k] = ((const u32x4*)hb)[i]; const f32x4* sp = (const f32x4*)(ssq + (i >> 7) * 16); sa[k] = sp[0]; sb[k] = sp[1]; sc[k] = sp[2]; sd[k] = sp[3]; } }
#pragma unroll
        for (int k = 0; k < 4; ++k) { const int i = i0 + k * c.nb * NTHR; if (i < NCH) {
            const f32x4 s4 = (sa[k] + sb[k]) + (sc[k] + sd[k]);
            const float r = rsqrtf((s4[0] + s4[1] + s4[2] + s4[3]) * (1.0f / DM) + 1e-6f);
            float4 o0, o1;
            o0.x = lo_f(w[k].x) * r * g0.x; o0.y = hi_f(w[k].x) * r * g0.y; o0.z = lo_f(w[k].y) * r * g0.z; o0.w = hi_f(w[k].y) * r * g0.w;
            o1.x = lo_f(w[k].z) * r * g1.x; o1.y = hi_f(w[k].z) * r * g1.y; o1.z = lo_f(w[k].w) * r * g1.z; o1.w = hi_f(w[k].w) * r * g1.w;
            ((float4*)out)[2 * i] = o0; ((float4*)out)[2 * i + 1] = o1; } }
    }
    (void)STRIDE;
}

DI void gmlp_stats_phase(const Ctx& c0, const bf16_t* big, float* stats) {
    const Ctx c = mk(c0);
    for (int row = c.bid * 8 + c.wave; row < T; row += c.nb * 8) {
        const u32x4* p = (const u32x4*)(big + (size_t)row * 4096 + 2048);
        float x[32]; float s = 0.f;
#pragma unroll
        for (int i = 0; i < 4; ++i) { const u32x4 w = p[c.lane + 64 * i];
            x[i * 8 + 0] = lo_f(w.x); x[i * 8 + 1] = hi_f(w.x); x[i * 8 + 2] = lo_f(w.y); x[i * 8 + 3] = hi_f(w.y);
            x[i * 8 + 4] = lo_f(w.z); x[i * 8 + 5] = hi_f(w.z); x[i * 8 + 6] = lo_f(w.w); x[i * 8 + 7] = hi_f(w.w); }
#pragma unroll
        for (int i = 0; i < 32; ++i) s += x[i];
        const float mean = wave_sum(s) * (1.0f / 2048.f);
        float q = 0.f;
#pragma unroll
        for (int i = 0; i < 32; ++i) { const float d = x[i] - mean; q += d * d; }
        q = wave_sum(q);
        if (c.lane == 0) { stats[2 * row] = mean; stats[2 * row + 1] = rsqrtf(q * (1.0f / 2048.f) + 1e-6f); }
    }
}
DI void gmlp_spatial_phase(const Ctx& c0, bf16_t* big, const float* vstat, const float* __restrict__ ws_, const float* __restrict__ bs_, const float* __restrict__ lng, const float* __restrict__ lnb) {
    const Ctx c = mk(c0);
    constexpr int P = 272;
    constexpr unsigned WS_O = 0, VS_O = 128 * P, ST_O = 256 * P;
    LAS float* ST = (LAS float*)(c.lds + ST_O);
    const int lane = c.lane, w = c.wave;
    int g_loaded = -1;
    for (int it = c.bid; it < 2048; it += c.nb) {
        const int chunk = it >> 4, g = it & 15;
        const int sr = c.tid >> 2, sq = c.tid & 3;
        const f32x4* stp = (const f32x4*)(vstat + ((size_t)(chunk * 128 + sr) * 32 + sq * 8) * 2);
        const f32x4 a0 = stp[0], a1 = stp[1], a2 = stp[2], a3 = stp[3];
        u32x4 vraw[4];
#pragma unroll
        for (int i = 0; i < 4; ++i) { const int idx = c.tid + 512 * i, s = idx >> 4, d8 = (idx & 15) * 8;
            vraw[i] = *(const u32x4*)(big + (size_t)(chunk * 128 + s) * 4096 + 2048 + g * 128 + d8); }
        const int t0 = 16 * w, t = t0 + (lane & 15), row = chunk * 128 + t, g4 = lane >> 4;
        u32x2 uraw[8];
#pragma unroll
        for (int dt = 0; dt < 8; ++dt) uraw[dt] = *(const u32x2*)(big + (size_t)row * 4096 + g * 128 + 16 * dt + 4 * g4);
        const float bsv = bs_[g * 128 + t];
        const int lcol = g * 128 + (c.tid & 15) * 8;
        const float4 g0 = *(const float4*)(lng + lcol), g1 = *(const float4*)(lng + lcol + 4), b0 = *(const float4*)(lnb + lcol), b1 = *(const float4*)(lnb + lcol + 4);
        if (g != g_loaded) {
            const float* Wg = ws_ + (size_t)g * 128 * 128;
            float4 wv8[8];
#pragma unroll
            for (int i = 0; i < 8; ++i) { const int idx = c.tid + 512 * i; wv8[i] = *(const float4*)(Wg + (idx >> 5) * 128 + (idx & 31) * 4); }
#pragma unroll
            for (int i = 0; i < 8; ++i) {
                const int idx = c.tid + 512 * i, tt = idx >> 5, s4 = (idx & 31) * 4;
                const float4 v = wv8[i];
                u32x2 o; o.x = pack2(s4 + 0 <= tt ? v.x : 0.f, s4 + 1 <= tt ? v.y : 0.f); o.y = pack2(s4 + 2 <= tt ? v.z : 0.f, s4 + 3 <= tt ? v.w : 0.f);
                *(LAS u32x2*)(c.lds + WS_O + tt * P + s4 * 2) = o;
            }
            g_loaded = g;
        }
        {
            float s1 = (a0[0] + a0[2]) + (a1[0] + a1[2]) + (a2[0] + a2[2]) + (a3[0] + a3[2]);
            float s2 = (a0[1] + a0[3]) + (a1[1] + a1[3]) + (a2[1] + a2[3]) + (a3[1] + a3[3]);
            s1 += __shfl_xor(s1, 1, 64); s1 += __shfl_xor(s1, 2, 64); s2 += __shfl_xor(s2, 1, 64); s2 += __shfl_xor(s2, 2, 64);
            const float mean = s1 * (1.0f / 2048.f), var = fmaxf(s2 * (1.0f / 2048.f) - mean * mean, 0.f);
            if (sq == 0) { ST[2 * sr] = mean; ST[2 * sr + 1] = rsqrtf(var + 1e-6f); }
        }
        __syncthreads();
#pragma unroll
        for (int i = 0; i < 4; ++i) {
            const int idx = c.tid + 512 * i, s = idx >> 4, d8 = (idx & 15) * 8;
            const int col = g * 128 + d8;
            const u32x4 raw = vraw[i];
            const float mean = ST[2 * s], rstd = ST[2 * s + 1];
            u32x4 o;
            o.x = pack2((lo_f(raw.x) - mean) * rstd * g0.x + b0.x, (hi_f(raw.x) - mean) * rstd * g0.y + b0.y);
            o.y = pack2((lo_f(raw.y) - mean) * rstd * g0.z + b0.z, (hi_f(raw.y) - mean) * rstd * g0.w + b0.w);
            o.z = pack2((lo_f(raw.z) - mean) * rstd * g1.x + b1.x, (hi_f(raw.z) - mean) * rstd * g1.y + b1.y);
            o.w = pack2((lo_f(raw.w) - mean) * rstd * g1.z + b1.z, (hi_f(raw.w) - mean) * rstd * g1.w + b1.w);
            *(LAS u32x4*)(c.lds + VS_O + s * P + d8 * 2) = o;
        }
        __syncthreads();
        f32x4 acc[8];
#pragma unroll
        for (int dt = 0; dt < 8; ++dt) acc[dt] = (f32x4){0.f, 0.f, 0.f, 0.f};
        for (int s0 = 0; s0 <= t0 + 15; s0 += 32) {
            const bf16x8 y = row_load(c.lds, WS_O, P, t0, s0, lane);
            const unsigned ta = tr_addr(c.ldsb + VS_O, P, s0, 0, lane);
#pragma unroll
            for (int dq = 0; dq < 2; ++dq) { bf16x8 x[4]; tr_load4(x, ta + 128 * dq, ta + 128 * dq + 32, ta + 128 * dq + 64, ta + 128 * dq + 96, P);
#pragma unroll
                for (int k = 0; k < 4; ++k) acc[4 * dq + k] = mfma16(x[k], y, acc[4 * dq + k]); }
        }
#pragma unroll
        for (int dt = 0; dt < 8; ++dt) {
            bf16_t* p = big + (size_t)row * 4096 + g * 128 + 16 * dt + 4 * g4;
            const u32x2 u = uraw[dt];
            u32x2 o; o.x = pack2(lo_f(u.x) * (acc[dt][0] + bsv), hi_f(u.x) * (acc[dt][1] + bsv)); o.y = pack2(lo_f(u.y) * (acc[dt][2] + bsv), hi_f(u.y) * (acc[dt][3] + bsv));
            *(u32x2*)p = o;
        }
        __syncthreads();
    }
}

DI void hgrn_local_phase(const Ctx& c0, bf16_t* big, bf16_t* states, float* dec, const float* __restrict__ lb_logits, int layer) {
    const Ctx c = mk(c0);
    constexpr int P = 272, PP = 144;
    constexpr int BP = 136;
    constexpr unsigned BC_O = 0, TOT_O = 64 * BP * 4, QM_O = TOT_O + 2048, KM_O = QM_O + 64 * P, KH_O = KM_O + 64 * P, IM_O = KH_O + 64 * P, PM_O = IM_O + 64 * P;
    LAS float* BC = (LAS float*)(c.lds + BC_O); LAS float* TOT = (LAS float*)(c.lds + TOT_O);
    LAS float* LBT = (LAS float*)(c.lds + PM_O + 64 * PP);
    const int lane = c.lane, w = c.wave, tid = c.tid;
    const int row = tid >> 3, c16 = (tid & 7) * 16;
    u32x4 qa, qb, ia, ib, fa, fb; float lb[16];
#define HL_LOAD(IT) do { const int bh_ = (IT) >> 7, ch_ = (IT) & 127, h_ = bh_ & 7; \
        const bf16_t* p_ = big + (size_t)((bh_ >> 3) * SEQ + ch_ * 64 + row) * 4096 + h_ * 128 + c16; \
        qa = *(const u32x4*)(p_); qb = *(const u32x4*)(p_ + 8); ia = *(const u32x4*)(p_ + 2048); ib = *(const u32x4*)(p_ + 2048 + 8); fa = *(const u32x4*)(p_ + 1024); fb = *(const u32x4*)(p_ + 1024 + 8); \
        _Pragma("unroll") for (int j = 0; j < 16; j += 4) { const f32x4 t4_ = *(const LAS f32x4*)(LBT + h_ * 128 + c16 + j); lb[j] = t4_[0]; lb[j + 1] = t4_[1]; lb[j + 2] = t4_[2]; lb[j + 3] = t4_[3]; } } while (0)
#pragma unroll
    for (int k = 0; k < 2; ++k) { const int d = tid + 512 * k;
        const float l0 = lb_logits[d], l1 = lb_logits[1024 + d], l2 = lb_logits[2048 + d], l3 = lb_logits[3072 + d];
        const float mx = fmaxf(fmaxf(l0, l1), fmaxf(l2, l3));
        const float e0 = __expf(l0 - mx), e1 = __expf(l1 - mx), e2 = __expf(l2 - mx), e3 = __expf(l3 - mx);
        float num = 0.f; if (layer >= 1) num += e1; if (layer >= 2) num += e2; if (layer >= 3) num += e3;
        LBT[d] = num / (e0 + e1 + e2 + e3); }
    __syncthreads();
    if (c.bid < 2048) HL_LOAD(c.bid);
    for (int it = c.bid; it < 2048; it += c.nb) {
        const int bh = it >> 7, ch = it & 127, b = bh >> 3, h = bh & 7;
        const int r0 = b * SEQ + ch * 64;
        bf16_t* prow = big + (size_t)(r0 + row) * 4096 + h * 128 + c16;
        float xf[16];
        { const u32x4 a = fa, bq = fb;
          xf[0] = lo_f(a.x); xf[1] = hi_f(a.x); xf[2] = lo_f(a.y); xf[3] = hi_f(a.y); xf[4] = lo_f(a.z); xf[5] = hi_f(a.z); xf[6] = lo_f(a.w); xf[7] = hi_f(a.w);
          xf[8] = lo_f(bq.x); xf[9] = hi_f(bq.x); xf[10] = lo_f(bq.y); xf[11] = hi_f(bq.y); xf[12] = lo_f(bq.z); xf[13] = hi_f(bq.z); xf[14] = lo_f(bq.w); xf[15] = hi_f(bq.w); }
#pragma unroll
        for (int j = 0; j < 16; ++j) { const float f = lb[j] + (1.0f - lb[j]) * sigmoidf_(xf[j]); BC[row * BP + j * 8 + (tid & 7)] = __logf(f); xf[j] = 1.0f - f; }
        __syncthreads();
        {
            const int d = tid & 127, seg = tid >> 7;
            float pre[16]; float run = 0.f;
#pragma unroll
            for (int j = 0; j < 16; ++j) { run += BC[(seg * 16 + j) * BP + d]; pre[j] = run; }
            TOT[seg * 128 + d] = run;
            __syncthreads();
            float off = 0.f;
            for (int s = 0; s < seg; ++s) off += TOT[s * 128 + d];
#pragma unroll
            for (int j = 0; j < 16; ++j) BC[(seg * 16 + j) * BP + d] = pre[j] + off;
        }
        __syncthreads();
        {
            float qv[16], iv_dummy;
            (void)iv_dummy;
            qv[0] = lo_f(qa.x); qv[1] = hi_f(qa.x); qv[2] = lo_f(qa.y); qv[3] = hi_f(qa.y); qv[4] = lo_f(qa.z); qv[5] = hi_f(qa.z); qv[6] = lo_f(qa.w); qv[7] = hi_f(qa.w);
            qv[8] = lo_f(qb.x); qv[9] = hi_f(qb.x); qv[10] = lo_f(qb.y); qv[11] = hi_f(qb.y); qv[12] = lo_f(qb.z); qv[13] = hi_f(qb.z); qv[14] = lo_f(qb.w); qv[15] = hi_f(qb.w);
            unsigned qm[8], km[8], kh[8], qi[8];
#pragma unroll
            for (int j = 0; j < 16; j += 2) {
                float o[2][4];
#pragma unroll
                for (int e = 0; e < 2; ++e) {
                    const int d = (j + e) * 8 + (tid & 7);
                    const float bc = BC[row * BP + d], bm = BC[31 * BP + d], bl = BC[63 * BP + d];
                    const float qs = siluf_(qv[j + e]);
                    const float kk = xf[j + e];
                    o[e][0] = qs * __expf(bc - bm); o[e][1] = kk * __expf(bm - bc); o[e][2] = kk * __expf(bl - bc); o[e][3] = qs * __expf(bc);
                }
                qm[j >> 1] = pack2(o[0][0], o[1][0]); km[j >> 1] = pack2(o[0][1], o[1][1]); kh[j >> 1] = pack2(o[0][2], o[1][2]); qi[j >> 1] = pack2(o[0][3], o[1][3]);
            }
            const unsigned off = row * P + c16 * 2;
            *(LAS u32x4*)(c.lds + QM_O + off) = (u32x4){qm[0], qm[1], qm[2], qm[3]}; *(LAS u32x4*)(c.lds + QM_O + off + 16) = (u32x4){qm[4], qm[5], qm[6], qm[7]};
            *(LAS u32x4*)(c.lds + KM_O + off) = (u32x4){km[0], km[1], km[2], km[3]}; *(LAS u32x4*)(c.lds + KM_O + off + 16) = (u32x4){km[4], km[5], km[6], km[7]};
            *(LAS u32x4*)(c.lds + KH_O + off) = (u32x4){kh[0], kh[1], kh[2], kh[3]}; *(LAS u32x4*)(c.lds + KH_O + off + 16) = (u32x4){kh[4], kh[5], kh[6], kh[7]};
            *(LAS u32x4*)(c.lds + IM_O + off) = ia; *(LAS u32x4*)(c.lds + IM_O + off + 16) = ib;
            *(u32x4*)(prow) = (u32x4){qi[0], qi[1], qi[2], qi[3]}; *(u32x4*)(prow + 8) = (u32x4){qi[4], qi[5], qi[6], qi[7]};
            if (tid < 128) dec[(size_t)it * 128 + tid] = __expf(BC[63 * BP + (tid & 15) * 8 + (tid >> 4)]);
        }
        __syncthreads();
        if (it + c.nb < 2048) HL_LOAD(it + c.nb);
        {
            const int ti = w >> 1;
#pragma unroll
            for (int k2 = 0; k2 < 2; ++k2) {
                const int si = 2 * (w & 1) + k2;
                f32x4 acc = (f32x4){0.f, 0.f, 0.f, 0.f};
                if (si <= ti) {
#pragma unroll
                    for (int d0 = 0; d0 < 128; d0 += 32) { const bf16x8 x = row_load(c.lds, QM_O, P, 16 * ti, d0, lane), y = row_load(c.lds, KM_O, P, 16 * si, d0, lane); acc = mfma16(x, y, acc); }
                }
                const int s = 16 * si + (lane & 15);
#pragma unroll
                for (int e = 0; e < 4; ++e) { const int t = 16 * ti + 4 * (lane >> 4) + e;
                    *(LAS bf16_t*)(c.lds + PM_O + t * PP + s * 2) = (bf16_t)((si <= ti && s <= t) ? f2bf(acc[e]) : 0u); }
            }
        }
        __syncthreads();
        {
            const int t0 = 16 * (w >> 1);
            const bf16x8 y0 = row_load(c.lds, PM_O, PP, t0, 0, lane), y1 = row_load(c.lds, PM_O, PP, t0, 32, lane);
            const int t = t0 + (lane & 15);
            bf16x8 xi0[4], xi1[4];
            { const unsigned ta = tr_addr(c.ldsb + IM_O, P, 0, 64 * (w & 1), lane); tr_load4(xi0, ta, ta + 32, ta + 64, ta + 96, P); tr_load4(xi1, ta + 32 * P, ta + 32 * P + 32, ta + 32 * P + 64, ta + 32 * P + 96, P); }
#pragma unroll
            for (int k4 = 0; k4 < 4; ++k4) {
                const int v0 = 16 * (4 * (w & 1) + k4);
                f32x4 acc = (f32x4){0.f, 0.f, 0.f, 0.f};
                acc = mfma16(xi0[k4], y0, acc);
                acc = mfma16(xi1[k4], y1, acc);
                u32x2 o; o.x = pack2(acc[0], acc[1]); o.y = pack2(acc[2], acc[3]);
                *(u32x2*)(big + (size_t)(r0 + t) * 4096 + 1024 + h * 128 + v0 + 4 * (lane >> 4)) = o;
            }
        }
        {
            const int v0 = 16 * w;
            const bf16x8 x0 = tr_load(c.ldsb + IM_O, P, 0, v0, lane), x1 = tr_load(c.ldsb + IM_O, P, 32, v0, lane);
            bf16_t* Sg = states + (size_t)it * 16384;
            const unsigned tk = tr_addr(c.ldsb + KH_O, P, 0, 0, lane);
#pragma unroll
            for (int dq = 0; dq < 2; ++dq) {
                bf16x8 ya[4], yb[4];
                tr_load4(ya, tk + 128 * dq, tk + 128 * dq + 32, tk + 128 * dq + 64, tk + 128 * dq + 96, P);
                tr_load4(yb, tk + 32 * P + 128 * dq, tk + 32 * P + 128 * dq + 32, tk + 32 * P + 128 * dq + 64, tk + 32 * P + 128 * dq + 96, P);
#pragma unroll
                for (int k = 0; k < 4; ++k) { const int dt = 4 * dq + k;
                    f32x4 acc = (f32x4){0.f, 0.f, 0.f, 0.f};
                    acc = mfma16(x0, ya[k], acc);
                    acc = mfma16(x1, yb[k], acc);
                    u32x2 o; o.x = pack2(acc[0], acc[1]); o.y = pack2(acc[2], acc[3]);
                    *(u32x2*)(Sg + (16 * dt + (lane & 15)) * 128 + v0 + 4 * (lane >> 4)) = o; }
            }
        }
        LDS_BAR();
    }
#undef HL_LOAD
}
DI void hgrn_scan_phase(const Ctx& c0, bf16_t* states, const float* dec) {
    const Ctx c = mk(c0);
    for (int gid = c.bid * NTHR + c.tid; gid < 16 * 8192; gid += c.nb * NTHR) {
        const int bh = gid >> 13, pr = gid & 8191, d = pr >> 6;
        unsigned* p = (unsigned*)(states + (size_t)bh * 128 * 16384) + pr;
        const float* dp = dec + (size_t)bh * 128 * 128 + d;
        float s0 = 0.f, s1 = 0.f;
        for (int cb = 0; cb < 128; cb += 4) {
            unsigned dv[4]; float dc[4];
#pragma unroll
            for (int j = 0; j < 4; ++j) { dv[j] = p[(size_t)(cb + j) * 8192]; dc[j] = dp[(cb + j) * 128]; }
#pragma unroll
            for (int j = 0; j < 4; ++j) { const unsigned o = pack2(s0, s1); s0 = dc[j] * s0 + lo_f(dv[j]); s1 = dc[j] * s1 + hi_f(dv[j]); dv[j] = o; }
#pragma unroll
            for (int j = 0; j < 4; ++j) p[(size_t)(cb + j) * 8192] = dv[j];
        }
    }
}
DI void hgrn_out_phase(const Ctx& c0, bf16_t* big, const bf16_t* states, const float* __restrict__ norm_g) {
    const Ctx c = mk(c0);
    constexpr int P = 272;
    constexpr unsigned SM_O = 0, QI_O = 128 * P, RED_O = QI_O + 64 * P;
    LAS float* RED = (LAS float*)(c.lds + RED_O);
    const int lane = c.lane, w = c.wave, tid = c.tid;
    for (int it = c.bid; it < 2048; it += c.nb) {
        const int bh = it >> 7, ch = it & 127, b = bh >> 3, h = bh & 7;
        const int r0 = b * SEQ + ch * 64;
        const bf16_t* Sg = states + (size_t)it * 16384;
        u32x4 sld[4], qld[2];
#pragma unroll
        for (int i = 0; i < 4; ++i) { const int idx = tid + 512 * i; sld[i] = *(const u32x4*)(Sg + (idx >> 4) * 128 + (idx & 15) * 8); }
#pragma unroll
        for (int i = 0; i < 2; ++i) { const int idx = tid + 512 * i; qld[i] = *(const u32x4*)(big + (size_t)(r0 + (idx >> 4)) * 4096 + h * 128 + (idx & 15) * 8); }
        const int t0 = 16 * (w & 3), vh = w >> 2;
        const int t = t0 + (lane & 15), g4 = lane >> 4;
        bf16_t* prow = big + (size_t)(r0 + t) * 4096 + h * 128;
        u32x2 oiv[4], gvv[4];
#pragma unroll
        for (int k4 = 0; k4 < 4; ++k4) { const int v = 16 * (4 * vh + k4) + 4 * g4; oiv[k4] = *(const u32x2*)(prow + 1024 + v); gvv[k4] = *(const u32x2*)(prow + 3072 + v); }
        float4 ngv[4];
#pragma unroll
        for (int k4 = 0; k4 < 4; ++k4) ngv[k4] = *(const float4*)(norm_g + h * 128 + 16 * (4 * vh + k4) + 4 * g4);
#pragma unroll
        for (int i = 0; i < 4; ++i) { const int idx = tid + 512 * i; *(LAS u32x4*)(c.lds + SM_O + (idx >> 4) * P + (idx & 15) * 16) = sld[i]; }
#pragma unroll
        for (int i = 0; i < 2; ++i) { const int idx = tid + 512 * i; *(LAS u32x4*)(c.lds + QI_O + (idx >> 4) * P + (idx & 15) * 16) = qld[i]; }
        __syncthreads();
        f32x4 acc[4];
#pragma unroll
        for (int k4 = 0; k4 < 4; ++k4) acc[k4] = (f32x4){0.f, 0.f, 0.f, 0.f};
#pragma unroll
        for (int d0 = 0; d0 < 128; d0 += 32) {
            const bf16x8 y = row_load(c.lds, QI_O, P, t0, d0, lane);
            bf16x8 x[4]; { const unsigned ta = tr_addr(c.ldsb + SM_O, P, d0, 64 * vh, lane); tr_load4(x, ta, ta + 32, ta + 64, ta + 96, P); }
#pragma unroll
            for (int k4 = 0; k4 < 4; ++k4) acc[k4] = mfma16(x[k4], y, acc[k4]);
        }
        float ss = 0.f;
#pragma unroll
        for (int k4 = 0; k4 < 4; ++k4) {
            const int v = 16 * (4 * vh + k4) + 4 * g4;
            const u32x2 oi = oiv[k4];
            acc[k4][0] += lo_f(oi.x); acc[k4][1] += hi_f(oi.x); acc[k4][2] += lo_f(oi.y); acc[k4][3] += hi_f(oi.y);
            ss += acc[k4][0] * acc[k4][0] + acc[k4][1] * acc[k4][1] + acc[k4][2] * acc[k4][2] + acc[k4][3] * acc[k4][3];
        }
        ss += __shfl_xor(ss, 16, 64); ss += __shfl_xor(ss, 32, 64);
        if (g4 == 0) RED[t * 2 + vh] = ss;
        __syncthreads();
        const float rstd = rsqrtf((RED[t * 2] + RED[t * 2 + 1]) * (1.0f / 128.f) + 1e-6f);
#pragma unroll
        for (int k4 = 0; k4 < 4; ++k4) {
            const int v = 16 * (4 * vh + k4) + 4 * g4;
            const u32x2 gv = gvv[k4];
            const float4 ng = ngv[k4];
            u32x2 o;
            o.x = pack2(acc[k4][0] * rstd * ng.x * siluf_(lo_f(gv.x)), acc[k4][1] * rstd * ng.y * siluf_(hi_f(gv.x)));
            o.y = pack2(acc[k4][2] * rstd * ng.z * siluf_(lo_f(gv.y)), acc[k4][3] * rstd * ng.w * siluf_(hi_f(gv.y)));
            *(u32x2*)(prow + 3072 + v) = o;
        }
        __syncthreads();
    }
}

DI void mlstm_conv_phase(const Ctx& cx, const bf16_t* big, bf16_t* CA, float* gates, const float* __restrict__ conv_w, const float* __restrict__ conv_b,
                         const float* __restrict__ wq, const float* __restrict__ wk, const float* __restrict__ wv, const float* __restrict__ wg, const float* __restrict__ bg) {
    const Ctx c = mk(cx);
    LAS float* GS = (LAS float*)c.lds;
    const int tid = c.tid, lane = c.lane, w = c.wave;
    const int c0 = 4 * tid;
    float cw[4][4], cb[4], wca[4][8], wvv[4][8];
#pragma unroll
    for (int j = 0; j < 4; ++j) { const float4 v = *(const float4*)(conv_w + j * 2048 + c0); cw[j][0] = v.x; cw[j][1] = v.y; cw[j][2] = v.z; cw[j][3] = v.w; }
    { const float4 v = *(const float4*)(conv_b + c0); cb[0] = v.x; cb[1] = v.y; cb[2] = v.z; cb[3] = v.w; }
#pragma unroll
    for (int d = 0; d < 4; ++d)
#pragma unroll
        for (int gi = 0; gi < 8; ++gi) { float a = 0.f, bsum = 0.f;
#pragma unroll
            for (int e = 0; e < 4; ++e) {
                a += wq[tid * 16 + d * 4 + e] * wg[(size_t)(c0 + e) * 8 + gi] + wk[tid * 16 + d * 4 + e] * wg[(size_t)(2048 + c0 + e) * 8 + gi];
                bsum += wv[tid * 16 + d * 4 + e] * wg[(size_t)(4096 + c0 + e) * 8 + gi]; }
            wca[d][gi] = a; wvv[d][gi] = bsum; }
    for (int it = c.bid; it < T / 16; it += c.nb) {
        const int r0 = it * 16;
        const bool first = (r0 % SEQ) == 0;
        u32x2 xs[19];
#pragma unroll
        for (int j = 0; j < 3; ++j) xs[j] = first ? (u32x2){0u, 0u} : *(const u32x2*)(big + (size_t)(r0 - 3 + j) * 4096 + c0);
#pragma unroll
        for (int j = 0; j < 16; ++j) xs[3 + j] = *(const u32x2*)(big + (size_t)(r0 + j) * 4096 + c0);
#pragma unroll
        for (int tt = 0; tt < 16; ++tt) {
            float x[4][4];
#pragma unroll
            for (int j = 0; j < 4; ++j) { x[j][0] = lo_f(xs[tt + j].x); x[j][1] = hi_f(xs[tt + j].x); x[j][2] = lo_f(xs[tt + j].y); x[j][3] = hi_f(xs[tt + j].y); }
            float ca[4];
#pragma unroll
            for (int e = 0; e < 4; ++e) ca[e] = siluf_(cb[e] + cw[0][e] * x[0][e] + cw[1][e] * x[1][e] + cw[2][e] * x[2][e] + cw[3][e] * x[3][e]);
            u32x2 o; o.x = pack2(ca[0], ca[1]); o.y = pack2(ca[2], ca[3]);
            *(u32x2*)(CA + (size_t)(r0 + tt) * 2048 + c0) = o;
            float p[8];
#pragma unroll
            for (int gi = 0; gi < 8; ++gi) { float a = 0.f;
#pragma unroll
                for (int e = 0; e < 4; ++e) a += ca[e] * wca[e][gi] + x[3][e] * wvv[e][gi];
                p[gi] = a; }
            const bool h1 = (lane & 32) != 0, h2 = (lane & 16) != 0, h3 = (lane & 8) != 0;
            float q4[4], r2[2];
#pragma unroll
            for (int j = 0; j < 4; ++j) { const float send = h1 ? p[j] : p[j + 4], keep = h1 ? p[j + 4] : p[j]; q4[j] = keep + __shfl_xor(send, 32, 64); }
#pragma unroll
            for (int j = 0; j < 2; ++j) { const float send = h2 ? q4[j] : q4[j + 2], keep = h2 ? q4[j + 2] : q4[j]; r2[j] = keep + __shfl_xor(send, 16, 64); }
            float s;
            { const float send = h3 ? r2[0] : r2[1], keep = h3 ? r2[1] : r2[0]; s = keep + __shfl_xor(send, 8, 64); }
            s += __shfl_xor(s, 4, 64); s += __shfl_xor(s, 2, 64); s += __shfl_xor(s, 1, 64);
            if ((lane & 7) == 0) GS[(w * 16 + tt) * 8 + (lane >> 3)] = s;
        }
        __syncthreads();
        if (tid < 128) { float a = bg[tid & 7];
#pragma unroll
            for (int ww = 0; ww < 8; ++ww) a += GS[ww * 128 + tid];
            gates[(size_t)r0 * 8 + tid] = a; }
        __syncthreads();
    }
}
struct QKW { float k[16]; };
DI void load_qkw(QKW& W, const float* __restrict__ wq, const float* __restrict__ wk, int h, int tid) {
    const int nb0 = h * 128 + (tid & 127);
#pragma unroll
    for (int cc = 0; cc < 4; ++cc)
#pragma unroll
        for (int d = 0; d < 4; ++d) { float a = 0.f;
#pragma unroll
            for (int e = 0; e < 4; ++e) a += wk[nb0 * 16 + cc * 4 + e] * wq[nb0 * 16 + d * 4 + e];
            W.k[cc * 4 + d] = a * 0.04419417382415922f; }
}
DI void qk_to_lds(LAS unsigned char* lds, unsigned q_o, unsigned k_o, const QKW& W, const u32x2 raw, int t, int cb) {
    const float x[4] = {lo_f(raw.x), hi_f(raw.x), lo_f(raw.y), hi_f(raw.y)};
    float k[4];
#pragma unroll
    for (int e = 0; e < 4; ++e) { float bsum = 0.f;
#pragma unroll
        for (int d = 0; d < 4; ++d) bsum += x[d] * W.k[d * 4 + e];
        k[e] = bsum; }
    const unsigned off = t * 1040 + cb * 8;
    *(LAS u32x2*)(lds + q_o + off) = raw;
    *(LAS u32x2*)(lds + k_o + off) = (u32x2){pack2(k[0], k[1]), pack2(k[2], k[3])};
}
DI void mlstm_smat_phase(const Ctx& c0, const bf16_t* CA, const float* gates, float* scal, bf16_t* Sg, const float* __restrict__ wq, const float* __restrict__ wk) {
    const Ctx c = mk(c0);
    constexpr int P = 1040;
    constexpr unsigned Q_O = 0, K_O = 64 * P, SC_O = 128 * P;
    LAS float* SC = (LAS float*)(c.lds + SC_O);
    const int lane = c.lane, w = c.wave, tid = c.tid;
    for (int it = c.bid; it < 1024; it += c.nb) {
        const int bh = it >> 7, ch = it & 127, b = bh >> 2, h = bh & 3;
        const int r0 = b * SEQ + ch * 64;
        if (w == 0) {
            const float gi = gates[(size_t)(r0 + lane) * 8 + h], gf = gates[(size_t)(r0 + lane) * 8 + 4 + h];
            const float lf = fminf(gf, 0.f) - log1pf(__expf(-fabsf(gf)));
            float a = lf;
#pragma unroll
            for (int o = 1; o < 64; o <<= 1) { const float v = __shfl_up(a, o, 64); if (lane >= o) a += v; }
            float pm = gi - a;
#pragma unroll
            for (int o = 1; o < 64; o <<= 1) { const float v = __shfl_up(pm, o, 64); if (lane >= o) pm = fmaxf(pm, v); }
            const float mloc = a + pm;
            const float alast = __shfl(a, 63, 64);
            const float gmax = wave_max(alast - a + gi);
            SC[lane] = a; SC[64 + lane] = gi; SC[128 + lane] = mloc;
            float* sp = scal + (size_t)it * 256;
            sp[lane] = a; sp[64 + lane] = gi; sp[128 + lane] = mloc; sp[192 + lane] = (lane == 0) ? gmax : alast;
        }
        QKW W; load_qkw(W, wq, wk, h, tid);
        {
            const int cb = tid & 127, tb = tid >> 7;
            u32x2 raw[16];
#pragma unroll
            for (int i = 0; i < 16; ++i) raw[i] = *(const u32x2*)(CA + (size_t)(r0 + tb + 4 * i) * 2048 + h * 512 + cb * 4);
#pragma unroll
            for (int i = 0; i < 16; ++i) qk_to_lds(c.lds, Q_O, K_O, W, raw[i], tb + 4 * i, cb);
        }
        __syncthreads();
        const int ti = w >> 1;
        bf16_t* So = Sg + (size_t)it * 4096;
#pragma unroll
        for (int k2 = 0; k2 < 2; ++k2) {
            const int si = 2 * (w & 1) + k2;
            f32x4 acc = (f32x4){0.f, 0.f, 0.f, 0.f};
            if (si <= ti) {
#pragma unroll 4
                for (int d0 = 0; d0 < 512; d0 += 32) { const bf16x8 x = row_load(c.lds, K_O, P, 16 * si, d0, lane), y = row_load(c.lds, Q_O, P, 16 * ti, d0, lane); acc = mfma16(x, y, acc); }
            }
            const int t = 16 * ti + (lane & 15);
            const float at = SC[t], mt = SC[128 + t];
            float o[4];
#pragma unroll
            for (int e = 0; e < 4; ++e) { const int s = 16 * si + 4 * (lane >> 4) + e;
                o[e] = (si <= ti && s <= t) ? acc[e] * __expf(at - SC[s] + SC[64 + s] - mt) : 0.f; }
            u32x2 ov; ov.x = pack2(o[0], o[1]); ov.y = pack2(o[2], o[3]);
            *(u32x2*)(So + t * 64 + 16 * si + 4 * (lane >> 4)) = ov;
        }
        __syncthreads();
    }
}
DI void mlstm_scan_phase(const Ctx& c0, bf16_t* big, const bf16_t* CA, const float* scal, const bf16_t* Sg, const float* __restrict__ wq, const float* __restrict__ wk, const float* __restrict__ wv) {
    const Ctx c = mk(c0);
    constexpr int PS = 144, PV = 80, PT = 136;
    constexpr unsigned PART_O = 0, SS_O = 69632, VA_O = SS_O + 64 * PS, VHT_O = VA_O + 64 * PV, SCL_O = VHT_O + 32 * PT, QT_O = SCL_O + 2048;
    LAS float* PART = (LAS float*)(c.lds + PART_O);
    LAS float* SCL = (LAS float*)(c.lds + SCL_O);
    const int lane = c.lane, w = c.wave, tid = c.tid, g4 = lane >> 4, l15 = lane & 15;
    for (int wi_ = c.bid; wi_ < 256; wi_ += c.nb) {
        const int bh = wi_ & 7, sl = wi_ >> 3, b = bh >> 2, h = bh & 3;
        const int vcol = h * 512 + sl * 16;
        bf16x8 mfr[4];
        {
            float4 wkr[4][4], wqr[4];
#pragma unroll
            for (int i4 = 0; i4 < 4; ++i4) { const int d = 64 * w + 16 * i4 + l15, nbk = (h * 512 + d) >> 2;
#pragma unroll
                for (int cc = 0; cc < 4; ++cc) wkr[i4][cc] = *(const float4*)(wk + nbk * 16 + cc * 4);
                wqr[i4] = *(const float4*)(wq + nbk * 16 + (d & 3) * 4); }
#pragma unroll
            for (int i4 = 0; i4 < 4; ++i4) {
                const int d = 64 * w + 16 * i4 + l15, cbase = 64 * w + 32 * (i4 >> 1);
                float m4[4];
#pragma unroll
                for (int cc = 0; cc < 4; ++cc) m4[cc] = 0.04419417382415922f * (wkr[i4][cc].x * wqr[i4].x + wkr[i4][cc].y * wqr[i4].y + wkr[i4][cc].z * wqr[i4].z + wkr[i4][cc].w * wqr[i4].w);
#pragma unroll
                for (int jj = 0; jj < 8; ++jj) {
                    const int cch = cbase + 16 * (jj >> 2) + 4 * g4 + (jj & 3);
                    mfr[i4][jj] = (short)f2bf(((cch >> 2) == (d >> 2)) ? m4[jj & 3] : 0.f);
                }
            }
        }
        LAS float* WVB = SCL + 448;
        if (tid < 64) WVB[tid] = wv[(vcol >> 2) * 16 + tid];
        __syncthreads();
        f32x4 accC[4][2];
#pragma unroll
        for (int i = 0; i < 4; ++i) { accC[i][0] = (f32x4){0.f, 0.f, 0.f, 0.f}; accC[i][1] = (f32x4){0.f, 0.f, 0.f, 0.f}; }
        float m_st = -INFINITY;
        u32x4 raw[8]; u32x4 sraw; u32x2 xraw = (u32x2){0u, 0u}; float sa = 0.f, sli = 0.f, sml = 0.f, sgm, sal;
        const int vs = tid >> 2;
#define MLSTM_PREFETCH(CH) do { const int it_ = bh * 128 + (CH); const int r0_ = b * SEQ + (CH) * 64; \
            _Pragma("unroll") for (int i = 0; i < 8; ++i) raw[i] = *(const u32x4*)(CA + (size_t)(r0_ + w + 8 * i) * 2048 + h * 512 + lane * 8); \
            sraw = *(const u32x4*)(Sg + (size_t)it_ * 4096 + tid * 8); \
            const float* sp_ = scal + (size_t)it_ * 256; \
            if (tid < 256) { xraw = *(const u32x2*)(big + (size_t)(r0_ + vs) * 4096 + vcol + 4 * (tid & 3)); sa = sp_[vs]; sli = sp_[64 + vs]; } \
            else if (tid < 320) { sa = sp_[tid - 256]; sml = sp_[128 + tid - 256]; } \
            sgm = sp_[192]; sal = sp_[193]; } while (0)
        unsigned hpend[4] = {0u, 0u, 0u, 0u};
        MLSTM_PREFETCH(0);
        for (int ch = 0; ch < 128; ++ch) {
            const int r0 = b * SEQ + ch * 64;
            LAS float* SC = SCL + (ch & 1) * 192;
            const float m_new = fmaxf(sal + m_st, sgm);
            const float dec = __expf(sal + m_st - m_new);
#pragma unroll
            for (int i = 0; i < 8; ++i) *(LAS u32x4*)(c.lds + QT_O + (w + 8 * i) * 1040 + lane * 16) = raw[i];
            *(LAS u32x4*)(c.lds + SS_O + (tid >> 3) * PS + (tid & 7) * 16) = sraw;
            if (tid < 256) {
                const float x[4] = {lo_f(xraw.x), hi_f(xraw.x), lo_f(xraw.y), hi_f(xraw.y)};
                float v[4];
                const int nb = tid & 3;
#pragma unroll
                for (int e = 0; e < 4; ++e) v[e] = x[0] * WVB[nb * 16 + e] + x[1] * WVB[nb * 16 + 4 + e] + x[2] * WVB[nb * 16 + 8 + e] + x[3] * WVB[nb * 16 + 12 + e];
                const float ws_ = __expf(sal - sa + sli - m_new);
                *(LAS u32x2*)(c.lds + VA_O + vs * PV + nb * 8) = (u32x2){pack2(v[0], v[1]), pack2(v[2], v[3])};
                *(LAS u32x2*)(c.lds + VA_O + vs * PV + 32 + nb * 8) = (u32x2){nb == 0 ? 0x3F80u : 0u, 0u};
#pragma unroll
                for (int e = 0; e < 4; ++e) {
                    *(LAS bf16_t*)(c.lds + VHT_O + (4 * nb + e) * PT + vs * 2) = (bf16_t)f2bf(v[e] * ws_);
                    *(LAS bf16_t*)(c.lds + VHT_O + (16 + 4 * nb + e) * PT + vs * 2) = (bf16_t)((nb == 0 && e == 0) ? f2bf(ws_) : 0u);
                }
            } else if (tid < 320) {
                const int t = tid - 256;
                const float mt = fmaxf(sml, sa + m_st);
                SC[t] = __expf(sml - mt); SC[64 + t] = __expf(sa + m_st - mt); SC[128 + t] = __expf(-mt);
            }
            LDS_BAR();
            if (ch + 1 < 128) MLSTM_PREFETCH(ch + 1);
            if (ch > 0 && (w & 1) == 0) {
#pragma unroll
                for (int e = 0; e < 4; ++e) big[(size_t)(r0 - 64 + 16 * (w >> 1) + 4 * g4 + e) * 4096 + vcol + l15] = (bf16_t)hpend[e];
            }
            u32x4 xa[4][2];
#pragma unroll
            for (int tt = 0; tt < 4; ++tt)
#pragma unroll
                for (int kk = 0; kk < 2; ++kk) {
                    const unsigned qo = QT_O + (16 * tt + l15) * 1040 + (64 * w + 32 * kk + 4 * g4) * 2;
                    const u32x2 lo_ = *(const LAS u32x2*)(c.lds + qo), hi_ = *(const LAS u32x2*)(c.lds + qo + 32);
                    xa[tt][kk] = (u32x4){lo_.x, lo_.y, hi_.x, hi_.y};
                }
            {
                f32x4 pacc[4][2];
#pragma unroll
                for (int tt = 0; tt < 4; ++tt) { pacc[tt][0] = (f32x4){0.f, 0.f, 0.f, 0.f}; pacc[tt][1] = (f32x4){0.f, 0.f, 0.f, 0.f}; }
#pragma unroll
                for (int kk = 0; kk < 2; ++kk) {
                    bf16x8 y[2];
#pragma unroll
                    for (int nt = 0; nt < 2; ++nt) {
                        u32x4 pk = (u32x4){pack2(accC[2 * kk][nt][0], accC[2 * kk][nt][1]), pack2(accC[2 * kk][nt][2], accC[2 * kk][nt][3]),
                                           pack2(accC[2 * kk + 1][nt][0], accC[2 * kk + 1][nt][1]), pack2(accC[2 * kk + 1][nt][2], accC[2 * kk + 1][nt][3])};
                        y[nt] = *(bf16x8*)&pk;
                    }
#pragma unroll
                    for (int tt = 0; tt < 4; ++tt) { const bf16x8 x = *(bf16x8*)&xa[tt][kk];
                        pacc[tt][0] = mfma16(x, y[0], pacc[tt][0]); pacc[tt][1] = mfma16(x, y[1], pacc[tt][1]); }
                }
#pragma unroll
                for (int tt = 0; tt < 4; ++tt)
#pragma unroll
                    for (int nt = 0; nt < 2; ++nt) *(LAS f32x4*)(PART + (w * 32 + 16 * nt + l15) * 68 + 16 * tt + 4 * g4) = pacc[tt][nt];
            }
            const int itt = w >> 1, intt = w & 1;
            f32x4 a2 = (f32x4){0.f, 0.f, 0.f, 0.f}, a3 = (f32x4){0.f, 0.f, 0.f, 0.f};
            if (intt == 0) {
                for (int s0 = 0; s0 <= 16 * itt + 15; s0 += 32) {
                    const bf16x8 xs = row_load(c.lds, SS_O, PS, 16 * itt, s0, lane);
                    a2 = mfma16(xs, tr_load(c.ldsb + VA_O, PV, s0, 0, lane), a2);
                    a3 = mfma16(xs, tr_load(c.ldsb + VA_O, PV, s0, 16, lane), a3);
                }
            }
            {
                bf16x8 yv[2][2];
#pragma unroll
                for (int k2 = 0; k2 < 2; ++k2)
#pragma unroll
                    for (int nt = 0; nt < 2; ++nt) {
                        const unsigned vo = VHT_O + (16 * nt + l15) * PT + (32 * k2 + 4 * g4) * 2;
                        const u32x2 lo_ = *(const LAS u32x2*)(c.lds + vo), hi_ = *(const LAS u32x2*)(c.lds + vo + 32);
                        u32x4 pk = (u32x4){lo_.x, lo_.y, hi_.x, hi_.y}; yv[k2][nt] = *(bf16x8*)&pk;
                    }
#pragma unroll
                for (int i4 = 0; i4 < 4; ++i4) {
                    accC[i4][0] = accC[i4][0] * dec; accC[i4][1] = accC[i4][1] * dec;
#pragma unroll
                    for (int k2 = 0; k2 < 2; ++k2) {
                        const f32x4 z = (f32x4){0.f, 0.f, 0.f, 0.f};
                        const f32x4 k0 = mfma16(*(bf16x8*)&xa[2 * k2][i4 >> 1], mfr[i4], z), k1 = mfma16(*(bf16x8*)&xa[2 * k2 + 1][i4 >> 1], mfr[i4], z);
                        u32x4 pk = (u32x4){pack2(k0[0], k0[1]), pack2(k0[2], k0[3]), pack2(k1[0], k1[1]), pack2(k1[2], k1[3])};
                        const bf16x8 kf = *(bf16x8*)&pk;
                        accC[i4][0] = mfma16(kf, yv[k2][0], accC[i4][0]); accC[i4][1] = mfma16(kf, yv[k2][1], accC[i4][1]);
                    }
                }
            }
            LDS_BAR();
            if (intt == 0) {
                f32x4 isum = (f32x4){0.f, 0.f, 0.f, 0.f}, dsum = (f32x4){0.f, 0.f, 0.f, 0.f};
#pragma unroll
                for (int ww = 0; ww < 8; ++ww) {
                    isum = isum + *(const LAS f32x4*)(PART + (ww * 32 + l15) * 68 + 16 * itt + 4 * g4);
                    dsum = dsum + *(const LAS f32x4*)(PART + (ww * 32 + 16) * 68 + 16 * itt + 4 * g4);
                }
#pragma unroll
                for (int e = 0; e < 4; ++e) {
                    const int t = 16 * itt + 4 * g4 + e;
                    const float a3e = __shfl(a3[e], lane & 48, 64);
                    const float den = fmaxf(fabsf(SC[t] * a3e + SC[64 + t] * dsum[e]), SC[128 + t]);
                    const float num = SC[t] * a2[e] + SC[64 + t] * isum[e];
                    hpend[e] = f2bf(num * __builtin_amdgcn_rcpf(den));
                }
            }
            m_st = m_new;
        }
        if ((w & 1) == 0) {
#pragma unroll
            for (int e = 0; e < 4; ++e) big[(size_t)(b * SEQ + 127 * 64 + 16 * (w >> 1) + 4 * g4 + e) * 4096 + vcol + l15] = (bf16_t)hpend[e];
        }
        __syncthreads();
#undef MLSTM_PREFETCH
    }
}
DI void mlstm_norm_phase(const Ctx& c0, const bf16_t* big, bf16_t* CA, const float* __restrict__ norm_g, const float* __restrict__ skip) {
    const Ctx c = mk(c0);
    for (int p0 = (c.bid * 8 + c.wave) * 4; p0 < T * 4; p0 += c.nb * 8 * 4) {
        const int row = p0 >> 2;
        u32x4 hr[4], zr[4], cr[4]; float4 gq[4][2], kq[4][2];
#pragma unroll
        for (int h = 0; h < 4; ++h) { const int col = h * 512 + 8 * c.lane;
            hr[h] = *(const u32x4*)(big + (size_t)row * 4096 + col); zr[h] = *(const u32x4*)(big + (size_t)row * 4096 + 2048 + col); cr[h] = *(const u32x4*)(CA + (size_t)row * 2048 + col);
            gq[h][0] = *(const float4*)(norm_g + col); gq[h][1] = *(const float4*)(norm_g + col + 4); kq[h][0] = *(const float4*)(skip + col); kq[h][1] = *(const float4*)(skip + col + 4); }
#pragma unroll
        for (int h = 0; h < 4; ++h) {
            const int col = h * 512 + 8 * c.lane;
            float x[8] = {lo_f(hr[h].x), hi_f(hr[h].x), lo_f(hr[h].y), hi_f(hr[h].y), lo_f(hr[h].z), hi_f(hr[h].z), lo_f(hr[h].w), hi_f(hr[h].w)};
            const float z[8] = {lo_f(zr[h].x), hi_f(zr[h].x), lo_f(zr[h].y), hi_f(zr[h].y), lo_f(zr[h].z), hi_f(zr[h].z), lo_f(zr[h].w), hi_f(zr[h].w)};
            const float ca[8] = {lo_f(cr[h].x), hi_f(cr[h].x), lo_f(cr[h].y), hi_f(cr[h].y), lo_f(cr[h].z), hi_f(cr[h].z), lo_f(cr[h].w), hi_f(cr[h].w)};
            float sm = 0.f;
#pragma unroll
            for (int i = 0; i < 8; ++i) sm += x[i];
            const float mean = wave_sum(sm) * (1.0f / 512.f);
            float q = 0.f;
#pragma unroll
            for (int i = 0; i < 8; ++i) { x[i] -= mean; q += x[i] * x[i]; }
            const float rstd = rsqrtf(wave_sum(q) * (1.0f / 512.f) + 1e-6f);
            const float4 g0 = gq[h][0], g1 = gq[h][1], k0 = kq[h][0], k1 = kq[h][1];
            const float gg[8] = {g0.x, g0.y, g0.z, g0.w, g1.x, g1.y, g1.z, g1.w}, sk[8] = {k0.x, k0.y, k0.z, k0.w, k1.x, k1.y, k1.z, k1.w};
            float o[8];
#pragma unroll
            for (int i = 0; i < 8; ++i) o[i] = (x[i] * rstd * gg[i] + sk[i] * ca[i]) * siluf_(z[i]);
            *(u32x4*)(CA + (size_t)row * 2048 + col) = (u32x4){pack2(o[0], o[1]), pack2(o[2], o[3]), pack2(o[4], o[5]), pack2(o[6], o[7])};
        }
    }
}

#ifndef PHSEL
#define PHSEL -1
#endif
#ifndef GSEL
#define GSEL -1
#endif
__global__ void __launch_bounds__(NTHR, 2) trunk_fwd(Args args) {
    extern __shared__ __attribute__((aligned(16))) unsigned char shm[];
    cg::grid_group grid = cg::this_grid();
    Ctx c;
    c.lds = (LAS unsigned char*)shm; c.ldsb = (unsigned)(uintptr_t)c.lds;
    c.tid = threadIdx.x; c.lane = c.tid & 63; c.wave = __builtin_amdgcn_readfirstlane(c.tid >> 6); c.bid = blockIdx.x; c.nb = gridDim.x;
    unsigned char* ws = args.ws;
    if (c.tid < 4) ((LAS unsigned*)(c.lds + LDS_BARST))[c.tid] = 0u;
    __syncthreads();
    const XcdBarrier xbar = xcd_barrier_post((unsigned*)(ws + WS_BAR), (volatile LAS unsigned*)(c.lds + LDS_BARST));
    bf16_t* Win = (bf16_t*)(ws + WS_WIN); bf16_t* Wout = (bf16_t*)(ws + WS_WOUT); bf16_t* W1 = (bf16_t*)(ws + WS_W1); bf16_t* W2 = (bf16_t*)(ws + WS_W2);
    bf16_t* HN = (bf16_t*)(ws + WS_HN); bf16_t* BIG = (bf16_t*)(ws + WS_BIG); bf16_t* CA = (bf16_t*)(ws + WS_CA);
    float* gates = (float*)(ws + WS_GATES); float* scal = (float*)(ws + WS_SCAL); float* dec = (float*)(ws + WS_DEC); float* stats = (float*)(ws + WS_STATS);
    bf16_t* SMAT = Win;
    float* H = args.out;
    const float* const* in = args.in;

    float* ssqA = (float*)(ws + WS_SSQA); float* ssqB = (float*)(ws + WS_SSQB);
#ifdef PROBE_L
    for (int pass = 0; pass < 2; ++pass)
#endif
    for (int layer = 0; layer < 4; ++layer) {
        const int kind = layer % 3, j = layer / 3;
        const int nmid = (kind == 0) ? 1 : (kind == 1 ? 3 : 4);
        const int nsteps = nmid + 5;
        for (int st = (layer == 0 ? 0 : 1); st < nsteps; ++st) {
#ifdef PROBE_L
            if (pass == 0 && (layer > PROBE_L || (layer == PROBE_L && st >= PROBE_S))) break;
#endif
            const int gsel = (st == 1) ? 0 : (st == nmid + 2) ? 1 : (st == nmid + 3) ? 2 : (st == nmid + 4) ? 3 : -1;
            if (gsel >= 0) {
                const bf16_t* A; const bf16_t* Bt; int lda, N, K, mode; const float* sin_ = ssqA; float* sout = ssqA;
                if (gsel == 0) { A = HN; lda = 1024; Bt = Win; N = 4096; K = 1024; mode = (kind == 0) ? 1 : 0; sin_ = ssqA; }
                else if (gsel == 1) { Bt = Wout; N = 1024; mode = 3; sout = ssqB;
                    if (kind == 0) { A = BIG; lda = 4096; K = 2048; } else if (kind == 1) { A = BIG + 3072; lda = 4096; K = 1024; } else { A = CA; lda = 2048; K = 2048; } }
                else if (gsel == 2) { A = HN; lda = 1024; Bt = W1; N = 4096; K = 1024; mode = 2; sin_ = ssqB; }
                else { A = BIG; lda = 4096; Bt = W2; N = 1024; K = 4096; mode = 3; sout = ssqA; }
                if (PHSEL < 0 || PHSEL == 2) run_gemm(c, A, lda, Bt, N, K, mode, BIG, HN, sin_, sout, (float*)CA);
                if (PHSEL < 0 || PHSEL == 0) {
                    if (gsel == 3 && layer < 3) {
                        const int nl = layer + 1, nk = nl % 3, nj = nl / 3;
                        const float* win = (nk == 0) ? in[7] + (size_t)nj * 1024 * 4096 : (nk == 1 ? in[13] : in[16]);
                        const float* wout = (nk == 0) ? in[12] + (size_t)nj * 2048 * 1024 : (nk == 1 ? in[15] : in[26]);
                        convert_wT(c, win, Win, 1024, 4096, in[1] + nl * 1024);
                        convert_wT(c, wout, Wout, nk == 1 ? 1024 : 2048, 1024, nullptr);
                        convert_wT(c, in[4] + (size_t)nl * 1024 * 4096, W1, 1024, 4096, in[2] + nl * 1024);
                    }
                    if (gsel == 0 && layer > 0) convert_wT(c, in[5] + (size_t)layer * 4096 * 1024, W2, 4096, 1024, nullptr);
                }
            } else if (st == 0) {
                const float* win = (kind == 0) ? in[7] + (size_t)j * 1024 * 4096 : (kind == 1 ? in[13] : in[16]);
                const float* wout = (kind == 0) ? in[12] + (size_t)j * 2048 * 1024 : (kind == 1 ? in[15] : in[26]);
                if (PHSEL < 0 || PHSEL == 0) {
                    convert_wT(c, win, Win, 1024, 4096, in[1] + layer * 1024);
                    convert_wT(c, wout, Wout, kind == 1 ? 1024 : 2048, 1024, nullptr);
                    convert_wT(c, in[4] + (size_t)layer * 1024 * 4096, W1, 1024, 4096, in[2] + layer * 1024);
                    convert_wT(c, in[5] + (size_t)layer * 4096 * 1024, W2, 4096, 1024, nullptr);
                }
                if (layer == 0) { if (PHSEL < 0 || PHSEL == 1) prologue_phase(c, in[0], HN, ssqA); }
            } else {
                const int m = st - 2;
                if (kind == 0) {
                    { if (PHSEL < 0 || PHSEL == 4) gmlp_spatial_phase(c, BIG, (const float*)CA, in[10] + (size_t)j * 16 * 128 * 128, in[11] + (size_t)j * 16 * 128, in[8] + (size_t)j * 2048, in[9] + (size_t)j * 2048); }
                } else if (kind == 1) {
                    if (m == 0) { if (PHSEL < 0 || PHSEL == 5) hgrn_local_phase(c, BIG, CA, dec, in[6], layer); }
                    else if (m == 1) { if (PHSEL < 0 || PHSEL == 6) hgrn_scan_phase(c, CA, dec); }
                    else { if (PHSEL < 0 || PHSEL == 7) hgrn_out_phase(c, BIG, CA, in[14]); }
                } else {
                    if (m == 0) { if (PHSEL < 0 || PHSEL == 8) mlstm_conv_phase(c, BIG, CA, gates, in[17], in[18], in[19], in[20], in[21], in[22], in[23]); }
                    else if (m == 1) { if (PHSEL < 0 || PHSEL == 9) mlstm_smat_phase(c, CA, gates, scal, SMAT, in[19], in[20]); }
                    else if (m == 2) { if (PHSEL < 0 || PHSEL == 10) mlstm_scan_phase(c, BIG, CA, scal, SMAT, in[19], in[20], in[21]); }
                    else { if (PHSEL < 0 || PHSEL == 11) mlstm_norm_phase(c, BIG, CA, in[25], in[24]); }
                }
            }
            if (args.use_cg) grid.sync();
            else xcd_barrier(xbar);
            if (layer == 0 && st == 0) {
                if (c.tid < 64) {
                    unsigned* bw = (unsigned*)(ws + WS_BAR);
                    const unsigned cnt = (c.tid < 16) ? xb_ld(&bw[XB_XCNT(c.tid)]) : 0u;
                    const bool good = (c.tid >= 16) || (cnt == (c.tid < 8 ? (unsigned)c.nb / 8u : 0u));
                    const bool ok = ((c.nb % 8) == 0) && (__ballot(good) == ~0ull);
                    volatile LAS unsigned* stw = (volatile LAS unsigned*)(c.lds + LDS_BARST);
                    if (c.tid == 0) stw[3] = ok ? stw[2] * 8u + xbar.x : (unsigned)blockIdx.x;
                }
                __syncthreads();
                c.bid = __builtin_amdgcn_readfirstlane((int)((volatile LAS unsigned*)(c.lds + LDS_BARST))[3]);
            }
        }
    }
    if (PHSEL < 0 || PHSEL == 12) final_norm_phase(c, HN, H, in[3], ssqA);
}

extern "C" void kernel_launch(void* const* d_in, const int* in_sizes, int n_in, void* d_out, int out_size, void* d_ws, size_t ws_size, hipStream_t stream) {
    static int grid = 0;
    if (grid == 0) {
        if (n_in != 27 || out_size != T * DM || ws_size < WS_END) { fprintf(stderr, "kernel_launch: unexpected shapes (n_in %d out %d ws %zu)\n", n_in, out_size, ws_size); grid = -1; return; }
        int dev = 0, cus = 0, per_cu = 0;
        hipGetDevice(&dev);
        hipDeviceGetAttribute(&cus, hipDeviceAttributeMultiprocessorCount, dev);
        if (hipFuncSetAttribute((const void*)trunk_fwd, hipFuncAttributeMaxDynamicSharedMemorySize, LDS_BYTES) != hipSuccess) { fprintf(stderr, "kernel_launch: hipFuncSetAttribute failed\n"); grid = -1; return; }
        if (hipOccupancyMaxActiveBlocksPerMultiprocessor(&per_cu, (const void*)trunk_fwd, NTHR, LDS_BYTES) != hipSuccess || per_cu < 1) { fprintf(stderr, "kernel_launch: occupancy query failed (%d)\n", per_cu); (void)hipGetLastError(); per_cu = 1; }
        grid = cus * 1;
        fprintf(stderr, "kernel_launch: grid %d (cus %d, per_cu %d)\n", grid, cus, per_cu);
    }
    if (grid < 0) return;
    if (hipMemsetAsync((char*)d_ws + WS_BAR, 0, XCD_BAR_WORDS * sizeof(unsigned), stream) != hipSuccess) { fprintf(stderr, "kernel_launch: memset of the barrier words failed\n"); return; }
    Args a{};
    for (int i = 0; i < 27; ++i) a.in[i] = (const float*)d_in[i];
    a.out = (float*)d_out; a.ws = (unsigned char*)d_ws; a.use_cg = 0; a.pad = 0;
    void* params[] = {&a};
    hipError_t e = hipLaunchCooperativeKernel((const void*)trunk_fwd, dim3(grid), dim3(NTHR), params, LDS_BYTES, stream);
    if (e != hipSuccess) fprintf(stderr, "kernel_launch: cooperative launch failed: %s\n", hipGetErrorString(e));
}
```

```cpp
#include <hip/hip_runtime.h>
#include <hip/hip_cooperative_groups.h>
#include <cstdio>
#include <cstdint>
namespace cg = cooperative_groups;

#define DI __device__ __forceinline__
#define LAS __attribute__((address_space(3)))
typedef unsigned short bf16_t;
typedef short bf16x8 __attribute__((ext_vector_type(8)));
typedef short s16x4 __attribute__((ext_vector_type(4)));
typedef float f32x4 __attribute__((ext_vector_type(4)));
typedef float f32x2 __attribute__((ext_vector_type(2)));
typedef unsigned u32x4 __attribute__((ext_vector_type(4)));
typedef unsigned u32x2 __attribute__((ext_vector_type(2)));

constexpr int T = 16384, DM = 1024, SEQ = 8192;
constexpr int NTHR = 512;
constexpr int LDS_BYTES = 157696;
constexpr int LDS_BARST = 157680;

constexpr size_t MB = 1024 * 1024;
constexpr size_t WS_WIN = 0;
constexpr size_t WS_WOUT = 8 * MB;
constexpr size_t WS_W1 = 12 * MB;
constexpr size_t WS_W2 = 20 * MB;
constexpr size_t WS_MISC = 28 * MB;
constexpr size_t WS_GATES = WS_MISC;
constexpr size_t WS_SCAL = WS_MISC + 512 * 1024;
constexpr size_t WS_DEC = WS_MISC;
constexpr size_t WS_STATS = WS_MISC;
constexpr size_t WS_SSQA = WS_MISC + 1536 * 1024;
constexpr size_t WS_SSQB = WS_MISC + 2560 * 1024;
constexpr size_t WS_BAR = WS_MISC + 3584 * 1024;
constexpr size_t WS_HN = 32 * MB;
constexpr size_t WS_BIG = 64 * MB;
constexpr size_t WS_CA = 192 * MB;
constexpr size_t WS_END = 256 * MB;

DI float bf2f(unsigned b) { return __uint_as_float(b << 16); }
typedef __bf16 nbf16x2 __attribute__((ext_vector_type(2)));
DI unsigned pack2(float lo, float hi) { nbf16x2 v; v.x = (__bf16)lo; v.y = (__bf16)hi; return __builtin_bit_cast(unsigned, v); }
DI unsigned f2bf(float f) { return pack2(f, 0.f) & 0xFFFFu; }
DI float lo_f(unsigned w) { return __uint_as_float(w << 16); }
DI float hi_f(unsigned w) { return __uint_as_float(w & 0xFFFF0000u); }
DI float sigmoidf_(float x) { return __builtin_amdgcn_rcpf(1.0f + __expf(-x)); }
DI float siluf_(float x) { return x * __builtin_amdgcn_rcpf(1.0f + __expf(-x)); }
DI float wave_sum(float v) {
#pragma unroll
    for (int o = 32; o >= 1; o >>= 1) v += __shfl_xor(v, o, 64);
    return v;
}
DI float wave_max(float v) {
#pragma unroll
    for (int o = 32; o >= 1; o >>= 1) v = fmaxf(v, __shfl_xor(v, o, 64));
    return v;
}
DI bf16x8 tr_frag(unsigned a0, unsigned a1) {
    s16x4 r0, r1;
    asm volatile("ds_read_b64_tr_b16 %0, %2\n\tds_read_b64_tr_b16 %1, %3\n\ts_waitcnt lgkmcnt(0)" : "=&v"(r0), "=&v"(r1) : "v"(a0), "v"(a1) : "memory");
    bf16x8 r; r[0] = r0[0]; r[1] = r0[1]; r[2] = r0[2]; r[3] = r0[3]; r[4] = r1[0]; r[5] = r1[1]; r[6] = r1[2]; r[7] = r1[3];
    return r;
}
DI unsigned tr_addr(unsigned base, int pitch, int k0, int n0, int lane) {
    const int g = lane >> 4, q = (lane & 15) >> 2, p = lane & 3;
    return base + (unsigned)((k0 + 8 * g + q) * pitch + (n0 + 4 * p) * 2);
}
DI bf16x8 tr_load(unsigned base, int pitch, int k0, int n0, int lane) { const unsigned a = tr_addr(base, pitch, k0, n0, lane); return tr_frag(a, a + 4 * pitch); }
DI void tr_load4(bf16x8 (&o)[4], unsigned a0, unsigned a1, unsigned a2, unsigned a3, int pitch) {
    s16x4 r0, r1, r2, r3, r4, r5, r6, r7;
    const unsigned b0 = a0 + 4 * pitch, b1 = a1 + 4 * pitch, b2 = a2 + 4 * pitch, b3 = a3 + 4 * pitch;
    asm volatile("ds_read_b64_tr_b16 %0, %8\n\tds_read_b64_tr_b16 %1, %9\n\tds_read_b64_tr_b16 %2, %10\n\tds_read_b64_tr_b16 %3, %11\n\t"
                 "ds_read_b64_tr_b16 %4, %12\n\tds_read_b64_tr_b16 %5, %13\n\tds_read_b64_tr_b16 %6, %14\n\tds_read_b64_tr_b16 %7, %15\n\ts_waitcnt lgkmcnt(0)"
                 : "=&v"(r0), "=&v"(r1), "=&v"(r2), "=&v"(r3), "=&v"(r4), "=&v"(r5), "=&v"(r6), "=&v"(r7)
                 : "v"(a0), "v"(b0), "v"(a1), "v"(b1), "v"(a2), "v"(b2), "v"(a3), "v"(b3) : "memory");
    o[0] = (bf16x8){r0[0], r0[1], r0[2], r0[3], r1[0], r1[1], r1[2], r1[3]};
    o[1] = (bf16x8){r2[0], r2[1], r2[2], r2[3], r3[0], r3[1], r3[2], r3[3]};
    o[2] = (bf16x8){r4[0], r4[1], r4[2], r4[3], r5[0], r5[1], r5[2], r5[3]};
    o[3] = (bf16x8){r6[0], r6[1], r6[2], r6[3], r7[0], r7[1], r7[2], r7[3]};
}
DI bf16x8 row_load(LAS unsigned char* lds, unsigned base, int pitch, int r0, int k0, int lane) {
    return *(const LAS bf16x8*)(lds + base + (unsigned)((r0 + (lane & 15)) * pitch + (k0 + 8 * (lane >> 4)) * 2));
}
#define LDS_BAR() do { asm volatile("s_waitcnt lgkmcnt(0)" ::: "memory"); __builtin_amdgcn_s_barrier(); asm volatile("" ::: "memory"); } while (0)
DI f32x4 mfma16(bf16x8 a, bf16x8 b, f32x4 c) { return __builtin_amdgcn_mfma_f32_16x16x32_bf16(a, b, c, 0, 0, 0); }

namespace pg8 {
constexpr int BM = 256, BK = 64, HALF = 128, HTB = HALF * BK * 2, STAGE_BYTES = 8 * HTB, NXCD = 8, WGM = 8;
DI int lds_byte(int r, int c) { const int st = (r >> 4) * 2 + (c >> 5), rr = r & 15, cc = c & 31, ob = rr * 64 + cc * 2; return st * 1024 + (ob ^ (((ob >> 9) & 1) << 5)); }
DI void stage_rc(int b, int& R, int& C) { const int st = b / 1024, sb = b % 1024, swz = sb ^ (((sb >> 9) & 1) << 5); R = (st >> 1) * 16 + swz / 64; C = (st & 1) * 32 + (swz % 64) / 2; }
DI int perm32(int rho) { const int n = rho >> 4, i = rho & 15; return 8 * (i >> 2) + 4 * n + (i & 3); }
struct Unit { int pm, pn; };
struct Gemm { const bf16_t* A; const bf16_t* Bt; int M, N, K, lda; };
struct StaticOrder {
    int nM, nN, nwg, G, c;
    DI void init(int M, int N, int G_, int c_) { nM = M / BM; nN = N / BM; nwg = nM * nN; G = G_; c = c_; }
    DI bool next(int i, Unit& u) const {
        const long L = (long)i * G + c; if (L >= nwg) return false;
        int wgid = (int)L; { const int q = nwg / NXCD, r = nwg % NXCD, xcd = wgid % NXCD, off = wgid / NXCD; wgid = (xcd < r ? xcd * (q + 1) : r * (q + 1) + (xcd - r) * q) + off; }
        const int nig = WGM * nN, gid = wgid / nig, fm = gid * WGM, gsz = (nM - fm) < WGM ? (nM - fm) : WGM;
        u.pm = fm + ((wgid % nig) % gsz); u.pn = (wgid % nig) / gsz; return true;
    }
};
DI unsigned cvt_pk_bf16(float lo, float hi) { unsigned r; asm volatile("v_cvt_pk_bf16_f32 %0, %1, %2" : "=v"(r) : "v"(lo), "v"(hi)); return r; }
DI f32x2 gelu_pk(f32x2 v) {
    const f32x2 av = __builtin_elementwise_abs(v), d = av * 0.2316418882f + 1.0f;
    f32x2 t; t.x = __builtin_amdgcn_rcpf(d.x); t.y = __builtin_amdgcn_rcpf(d.y);
    f32x2 q = t * 0.5307027145f + (-0.7265760135f); q = q * t + 0.7107068705f; q = q * t + (-0.142248368f); q = q * t + 0.127414796f; q = q * t;
    const f32x2 s = (v * v) * (-0.72134752044f);
    f32x2 e; e.x = __builtin_amdgcn_exp2f(s.x); e.y = __builtin_amdgcn_exp2f(s.y);
    const f32x2 m = v * (q * e), r = v - m;
    f32x2 o; o.x = v.x < 0.f ? m.x : r.x; o.y = v.y < 0.f ? m.y : r.y; return o;
}
struct EpiAny {
    int mode; bf16_t* O; bf16_t* HB; const LAS float* rstd_tab; float* ssq_out; float* vstat;
    DI bool perm() const { return true; }
    DI void operator()(const f32x4 (&acc)[2][2][4][2], const Unit& u, int wr, int wc, int fr, int fq, int ui) const {
        if (mode == 3) {
            const int row0 = u.pm * BM + wr * 64 + fr, col0 = u.pn * BM + wc * 32 + 8 * fq;
#pragma unroll
            for (int ai = 0; ai < 2; ++ai) {
                u32x4 oldv[4][2];
#pragma unroll
                for (int m = 0; m < 4; ++m)
#pragma unroll
                    for (int bj = 0; bj < 2; ++bj) oldv[m][bj] = *(const u32x4*)(HB + (size_t)(row0 + ai * HALF + m * 16) * 1024 + col0 + bj * HALF);
#pragma unroll
                for (int m = 0; m < 4; ++m) { const int row = row0 + ai * HALF + m * 16; bf16_t* hb = HB + (size_t)row * 1024 + col0;
                    float ss = 0.f;
#pragma unroll
                    for (int bj = 0; bj < 2; ++bj) { const u32x4 old = oldv[m][bj];
                        const f32x4 a0 = acc[ai][bj][m][0], a1 = acc[ai][bj][m][1];
                        u32x4 w; w.x = cvt_pk_bf16(lo_f(old.x) + a0[0], hi_f(old.x) + a0[1]); w.y = cvt_pk_bf16(lo_f(old.y) + a0[2], hi_f(old.y) + a0[3]);
                        w.z = cvt_pk_bf16(lo_f(old.z) + a1[0], hi_f(old.z) + a1[1]); w.w = cvt_pk_bf16(lo_f(old.w) + a1[2], hi_f(old.w) + a1[3]);
                        *(u32x4*)(hb + bj * HALF) = w;
                        const float r0 = lo_f(w.x), r1 = hi_f(w.x), r2 = lo_f(w.y), r3 = hi_f(w.y), r4 = lo_f(w.z), r5 = hi_f(w.z), r6 = lo_f(w.w), r7 = hi_f(w.w);
                        ss += (r0 * r0 + r1 * r1) + (r2 * r2 + r3 * r3) + (r4 * r4 + r5 * r5) + (r6 * r6 + r7 * r7); }
                    ss += __shfl_xor(ss, 16, 64); ss += __shfl_xor(ss, 32, 64);
                    if (fq == 0) ssq_out[row * 16 + u.pn * 4 + wc] = ss; }
            }
        } else {
            const int row0 = u.pm * BM + wr * 64 + fr, col0 = u.pn * BM + wc * 32 + 8 * fq;
#pragma unroll
            for (int ai = 0; ai < 2; ++ai)
#pragma unroll
                for (int m = 0; m < 4; ++m) { const int row = row0 + ai * HALF + m * 16; bf16_t* rowp = O + (size_t)row * 4096 + col0;
                    const float rs = rstd_tab[(ui & 3) * 256 + wr * 64 + fr + ai * HALF + m * 16];
                    float st1 = 0.f, st2 = 0.f;
#pragma unroll
                    for (int bj = 0; bj < 2; ++bj) { f32x4 v0 = acc[ai][bj][m][0] * rs, v1 = acc[ai][bj][m][1] * rs;
                        if (mode == 1) { f32x2 a = gelu_pk((f32x2){v0[0], v0[1]}), b = gelu_pk((f32x2){v0[2], v0[3]}), c = gelu_pk((f32x2){v1[0], v1[1]}), d = gelu_pk((f32x2){v1[2], v1[3]});
                            v0 = (f32x4){a.x, a.y, b.x, b.y}; v1 = (f32x4){c.x, c.y, d.x, d.y}; }
                        else if (mode == 2) {
#pragma unroll
                            for (int j = 0; j < 4; ++j) { const float a = fmaxf(v0[j], 0.f), b = fmaxf(v1[j], 0.f); v0[j] = a * a; v1[j] = b * b; } }
                        u32x4 w; w.x = cvt_pk_bf16(v0[0], v0[1]); w.y = cvt_pk_bf16(v0[2], v0[3]); w.z = cvt_pk_bf16(v1[0], v1[1]); w.w = cvt_pk_bf16(v1[2], v1[3]);
                        *(u32x4*)(rowp + bj * HALF) = w;
                        if (mode == 1 && u.pn >= 8) {
                            const float r0 = lo_f(w.x), r1 = hi_f(w.x), r2 = lo_f(w.y), r3 = hi_f(w.y), r4 = lo_f(w.z), r5 = hi_f(w.z), r6 = lo_f(w.w), r7 = hi_f(w.w);
                            st1 += (r0 + r1) + (r2 + r3) + (r4 + r5) + (r6 + r7);
                            st2 += (r0 * r0 + r1 * r1) + (r2 * r2 + r3 * r3) + (r4 * r4 + r5 * r5) + (r6 * r6 + r7 * r7); } }
                    if (mode == 1 && u.pn >= 8) {
                        st1 += __shfl_xor(st1, 16, 64); st1 += __shfl_xor(st1, 32, 64); st2 += __shfl_xor(st2, 16, 64); st2 += __shfl_xor(st2, 32, 64);
                        if (fq == 0) *(f32x2*)(vstat + ((size_t)row * 32 + (u.pn - 8) * 4 + wc) * 2) = (f32x2){st1, st2}; } }
        }
    }
};

template <class Epi, class Sched>
DI void gemm_phase(LAS unsigned char* lds, const Gemm g, const Sched& S, const Epi& E, const int tid) {
    const int wid = __builtin_amdgcn_readfirstlane(tid >> 6), lane = tid & 63, wr = wid >> 2, wc = wid & 3, fr = lane & 15, fq = lane >> 4;
    const int K = g.K, nt = K / BK;
    unsigned voffA[2], voffB[2];
#pragma unroll
    for (int i = 0; i < 2; ++i) { int R, C; stage_rc(tid * 16 + i * 8192, R, C); const int Rb = E.perm() ? ((R & ~31) + perm32(R & 31)) : R;
        voffA[i] = (unsigned)(R * g.lda + C) * 2u; voffB[i] = (unsigned)(Rb * K + C) * 2u; }
    const size_t kstep = (size_t)(BK * 2);
    const size_t hstepA = (size_t)HALF * g.lda * 2, hstepB = (size_t)HALF * K * 2;
    const size_t tstepA = 2 * hstepA, tstepB = 2 * hstepB;
    const unsigned ldsw = (unsigned)wid * 1024u;
    const int aoff = lds_byte(wr * 64 + fr, fq * 8), boff = lds_byte(wc * 32 + fr, fq * 8);
#define PG8_SA(b, h) (((b) * 2 + (h)) * HTB)
#define PG8_SB(b, h) ((4 + (b) * 2 + (h)) * HTB)
#define PG8_STAGE(bufoff, gbase, voff) do { _Pragma("unroll") for (int _i = 0; _i < 2; ++_i) \
        __builtin_amdgcn_global_load_lds((const unsigned*)((const char*)(gbase) + (voff)[_i]), (LAS unsigned*)(lds + (bufoff) + ldsw + _i * 8192), 16, 0, 0); } while (0)
#define PG8_LDA(dst, b, h) do { _Pragma("unroll") for (int m = 0; m < 4; ++m) _Pragma("unroll") for (int k = 0; k < 2; ++k) dst[m][k] = *(const LAS bf16x8*)(lds + PG8_SA(b, h) + aoff + m * 2048 + k * 1024); } while (0)
#define PG8_LDB(dst, b, h) do { _Pragma("unroll") for (int n = 0; n < 2; ++n) _Pragma("unroll") for (int k = 0; k < 2; ++k) dst[n][k] = *(const LAS bf16x8*)(lds + PG8_SB(b, h) + boff + n * 2048 + k * 1024); } while (0)
#define PG8_MMA(ai, bj, At, Bt) do { __builtin_amdgcn_s_setprio(1); _Pragma("unroll") for (int m = 0; m < 4; ++m) _Pragma("unroll") for (int n = 0; n < 2; ++n) _Pragma("unroll") for (int k = 0; k < 2; ++k) \
        acc[ai][bj][m][n] = __builtin_amdgcn_mfma_f32_16x16x32_bf16(Bt[n][k], At[m][k], acc[ai][bj][m][n], 0, 0, 0); __builtin_amdgcn_s_setprio(0); } while (0)
#define PG8_WAIT_V(n) asm volatile("s_waitcnt vmcnt(" #n ")" ::: "memory")
#define PG8_WAIT_L(n) asm volatile("s_waitcnt lgkmcnt(" #n ")" ::: "memory")
#define PG8_BAR __builtin_amdgcn_s_barrier()
#define PG8_SCHED __builtin_amdgcn_sched_barrier(0)
    Unit cur, nxt; int ui = 0;
    if (!S.next(0, cur)) return;
    f32x4 acc[2][2][4][2];
#pragma unroll
    for (int a = 0; a < 2; ++a)
#pragma unroll
        for (int b = 0; b < 2; ++b)
#pragma unroll
            for (int m = 0; m < 4; ++m)
#pragma unroll
                for (int n = 0; n < 2; ++n) acc[a][b][m][n] = (f32x4){0.f, 0.f, 0.f, 0.f};
    bf16x8 At[4][2], B0[2][2], B1[2][2];
    const char* cA = (const char*)g.A + (size_t)cur.pm * tstepA; const char* cB = (const char*)g.Bt + (size_t)cur.pn * tstepB;
    PG8_STAGE(PG8_SB(0, 0), cB, voffB); PG8_STAGE(PG8_SA(0, 0), cA, voffA); PG8_STAGE(PG8_SB(0, 1), cB + hstepB, voffB); PG8_STAGE(PG8_SA(0, 1), cA + hstepA, voffA);
    if (wr == 1) PG8_BAR;
    PG8_WAIT_V(4); PG8_BAR;
    PG8_STAGE(PG8_SB(1, 0), cB + kstep, voffB); PG8_STAGE(PG8_SA(1, 0), cA + kstep, voffA); PG8_STAGE(PG8_SB(1, 1), cB + hstepB + kstep, voffB);
    PG8_WAIT_V(6); PG8_BAR;
    for (;;) {
        const bool has_next = S.next(ui + 1, nxt);
        const char* nA = has_next ? (const char*)g.A + (size_t)nxt.pm * tstepA : cA; const char* nB = has_next ? (const char*)g.Bt + (size_t)nxt.pn * tstepB : cB;
        for (int t = 0; t < nt; t += 2) {
            const bool last = (t == nt - 2);
            const char* a1 = cA + (size_t)(t + 1) * kstep;
            const char* a2 = last ? nA : cA + (size_t)(t + 2) * kstep; const char* b2 = last ? nB : cB + (size_t)(t + 2) * kstep;
            const char* a3 = a2 + kstep; const char* b3 = b2 + kstep;
            PG8_LDB(B0, 0, 0); PG8_SCHED; PG8_LDA(At, 0, 0); PG8_STAGE(PG8_SA(1, 1), a1 + hstepA, voffA);
            PG8_WAIT_L(8); PG8_BAR; PG8_WAIT_L(0); PG8_MMA(0, 0, At, B0); PG8_BAR; PG8_SCHED;
            PG8_LDB(B1, 0, 1); PG8_STAGE(PG8_SB(0, 0), b2, voffB);
            PG8_BAR; PG8_WAIT_L(0); PG8_MMA(0, 1, At, B1); PG8_BAR;
            PG8_LDA(At, 0, 1); PG8_STAGE(PG8_SA(0, 0), a2, voffA);
            PG8_BAR; PG8_WAIT_L(0); PG8_MMA(1, 0, At, B0); PG8_BAR; PG8_SCHED;
            PG8_STAGE(PG8_SB(0, 1), b2 + hstepB, voffB);
            PG8_WAIT_V(6); PG8_BAR; PG8_MMA(1, 1, At, B1); PG8_BAR;
            PG8_LDB(B0, 1, 0); PG8_SCHED; PG8_LDA(At, 1, 0); PG8_STAGE(PG8_SA(0, 1), a2 + hstepA, voffA);
            PG8_WAIT_L(8); PG8_BAR; PG8_WAIT_L(0); PG8_MMA(0, 0, At, B0); PG8_BAR; PG8_SCHED;
            PG8_LDB(B1, 1, 1); PG8_STAGE(PG8_SB(1, 0), b3, voffB);
            PG8_BAR; PG8_WAIT_L(0); PG8_MMA(0, 1, At, B1); PG8_BAR;
            PG8_LDA(At, 1, 1); PG8_STAGE(PG8_SA(1, 0), a3, voffA);
            PG8_BAR; PG8_WAIT_L(0); PG8_MMA(1, 0, At, B0); PG8_BAR; PG8_SCHED;
            PG8_STAGE(PG8_SB(1, 1), b3 + hstepB, voffB);
            PG8_WAIT_V(6); PG8_BAR; PG8_MMA(1, 1, At, B1); PG8_BAR;
        }
        E(acc, cur, wr, wc, fr, fq, ui);
        if (!has_next) break;
#pragma unroll
        for (int a = 0; a < 2; ++a)
#pragma unroll
            for (int b = 0; b < 2; ++b)
#pragma unroll
                for (int m = 0; m < 4; ++m)
#pragma unroll
                    for (int n = 0; n < 2; ++n) acc[a][b][m][n] = (f32x4){0.f, 0.f, 0.f, 0.f};
        cur = nxt; cA = nA; cB = nB; ++ui;
    }
    PG8_WAIT_V(0);
    if (wr == 0) PG8_BAR;
    PG8_BAR;
#undef PG8_SA
#undef PG8_SB
#undef PG8_STAGE
#undef PG8_LDA
#undef PG8_LDB
#undef PG8_MMA
#undef PG8_WAIT_V
#undef PG8_WAIT_L
#undef PG8_BAR
#undef PG8_SCHED
}
}

#define XB_TMO      128
#define XB_XCNT(j)  (256  + 64 * (j))
#define XB_XSUB(j)  (1280 + 64 * (j))
#define XB_XGEN(j)  (2304 + 64 * (j))
#define XB_TOP      3328
#define XB_TOPGEN   3392
#define XCD_BAR_WORDS 3456
#define XB_SPIN_CAP (1u << 18)
DI unsigned xb_ld(unsigned* p)              { return __hip_atomic_load(p, __ATOMIC_RELAXED, __HIP_MEMORY_SCOPE_AGENT); }
DI unsigned xb_add(unsigned* p, unsigned v) { return __hip_atomic_fetch_add(p, v, __ATOMIC_RELAXED, __HIP_MEMORY_SCOPE_AGENT); }
DI unsigned xb_xcc_id() { return (unsigned)__builtin_amdgcn_s_getreg((3 << 11) | 20) & 0xFu; }
#define XB_SPIN(cond, bar) do { unsigned _sp = 0; while (cond) { __builtin_amdgcn_s_sleep(1); \
    if ((++_sp & 255u) == 0u) { if (xb_ld(&(bar)[XB_TMO])) break; if (_sp > XB_SPIN_CAP) { atomicAdd(&(bar)[XB_TMO], 1u); break; } } } } while (0)
struct XcdBarrier { unsigned* bar; unsigned x; volatile LAS unsigned* st; };
DI XcdBarrier xcd_barrier_post(unsigned* bar, volatile LAS unsigned* st) {
    XcdBarrier b; b.bar = bar; b.x = xb_xcc_id(); b.st = st;
    if (threadIdx.x == 0) st[2] = xb_add(&bar[XB_XCNT(b.x)], 1u);
    return b;
}
DI void xcd_barrier_complete(unsigned* bar, unsigned x, unsigned& nloc, unsigned& nx) {
    const unsigned G = gridDim.x * gridDim.y * gridDim.z;
    unsigned sum, cnt, mine, sp = 0u;
    for (;;) {
        sum = 0u; cnt = 0u; mine = 0u;
#pragma unroll
        for (unsigned j = 0; j < 16; ++j) { const unsigned c = xb_ld(&bar[XB_XCNT(j)]); sum += c; cnt += (c > 0u) ? 1u : 0u; mine = (j == x) ? c : mine; }
        if (sum == G) break;
        __builtin_amdgcn_s_sleep(1);
        if ((++sp & 255u) == 0u) { if (xb_ld(&bar[XB_TMO])) break; if (sp > XB_SPIN_CAP) { atomicAdd(&bar[XB_TMO], 1u); break; } }
    }
    nloc = mine > 0u ? mine : 1u; nx = cnt > 0u ? cnt : 1u;
}
DI void xcd_barrier_census_wave0(const XcdBarrier& b) {
    const unsigned lane = threadIdx.x & 63u, G = gridDim.x * gridDim.y * gridDim.z;
    unsigned cnt, sum, sp = 0u;
    for (;;) {
        cnt = (lane < 16u) ? xb_ld(&b.bar[XB_XCNT(lane)]) : 0u;
        sum = cnt;
#pragma unroll
        for (int o = 32; o >= 1; o >>= 1) sum += __shfl_xor(sum, o, 64);
        if (sum == G) break;
        __builtin_amdgcn_s_sleep(1);
        if ((++sp & 255u) == 0u) { if (xb_ld(&b.bar[XB_TMO])) break; if (sp > XB_SPIN_CAP) { if (lane == 0u) atomicAdd(&b.bar[XB_TMO], 1u); break; } }
    }
    const unsigned nx = (unsigned)__popcll(__ballot(cnt > 0u)), mine = __shfl(cnt, (int)b.x, 64);
    if (lane == 0u) { b.st[0] = mine > 0u ? mine : 1u; b.st[1] = nx > 0u ? nx : 1u; }
}
DI void xcd_barrier(const XcdBarrier& b) {
    asm volatile("s_waitcnt vmcnt(0)" ::: "memory");
    __syncthreads();
    if (threadIdx.x < 64 && b.st[0] == 0u) xcd_barrier_census_wave0(b);
    if (threadIdx.x == 0) {
        unsigned* bar = b.bar;
        __builtin_amdgcn_s_waitcnt(0);
        unsigned nloc = b.st[0], nx = b.st[1];
        if (nloc == 0u) { xcd_barrier_complete(bar, b.x, nloc, nx); b.st[0] = nloc; b.st[1] = nx; }
        const unsigned old = xb_add(&bar[XB_XSUB(b.x)], 1u);
        const unsigned gen = old / nloc;
        if (old + 1u == (gen + 1u) * nloc) {
            __builtin_amdgcn_fence(__ATOMIC_RELEASE, "agent");
            asm volatile("s_waitcnt vmcnt(0)" ::: "memory");
            const unsigned og = xb_add(&bar[XB_TOP], 1u);
            const unsigned tg = og / nx;
            if (og + 1u == (tg + 1u) * nx) xb_add(&bar[XB_TOPGEN], 1u);
            else XB_SPIN(xb_ld(&bar[XB_TOPGEN]) == tg, bar);
            __builtin_amdgcn_fence(__ATOMIC_ACQUIRE, "agent");
            xb_add(&bar[XB_XGEN(b.x)], 1u);
            asm volatile("s_waitcnt vmcnt(0)" ::: "memory");
        } else {
            XB_SPIN(xb_ld(&bar[XB_XGEN(b.x)]) == gen, bar);
            __builtin_amdgcn_fence(__ATOMIC_ACQUIRE, "agent");
            asm volatile("s_waitcnt vmcnt(0)" ::: "memory");
        }
    }
    __syncthreads();
}

struct Args {
    const float* in[27];
    float* out;
    unsigned char* ws;
    int use_cg, pad;
};
struct Ctx {
    LAS unsigned char* lds; unsigned ldsb;
    int tid, lane, wave, bid, nb;
};

DI Ctx mk(const Ctx& c0) {
    Ctx c = c0; int t = threadIdx.x; asm volatile("" : "+v"(t)); int b = c0.bid, n = c0.nb; asm volatile("" : "+s"(b), "+s"(n));
    c.tid = t; c.lane = t & 63; c.wave = __builtin_amdgcn_readfirstlane(t >> 6); c.bid = b; c.nb = n; return c;
}
DI void run_gemm(const Ctx& c0, const bf16_t* A, int lda, const bf16_t* Bt, int N, int K, int mode, bf16_t* O, bf16_t* HB, const float* ssq_in, float* ssq_out, float* vstat) {
    const Ctx c = mk(c0);
    pg8::Gemm g{A, Bt, T, N, K, lda};
    pg8::StaticOrder S; S.init(T, N, c.nb, c.bid);
    LAS float* tab = (LAS float*)(c.lds + pg8::STAGE_BYTES);
    if (mode != 3) {
        pg8::Unit u;
        if (S.next(c.tid >> 7, u)) {
#pragma unroll
            for (int k = 0; k < 2; ++k) { const int r = (c.tid & 127) + 128 * k; const f32x4* sp = (const f32x4*)(ssq_in + (size_t)(u.pm * 256 + r) * 16);
                const f32x4 s4 = (sp[0] + sp[1]) + (sp[2] + sp[3]);
                tab[(c.tid >> 7) * 256 + r] = rsqrtf((s4[0] + s4[1] + s4[2] + s4[3]) * (1.0f / 1024.f) + 1e-6f); }
        }
        __syncthreads();
    }
    pg8::gemm_phase<pg8::EpiAny, pg8::StaticOrder>(c.lds, g, S, pg8::EpiAny{mode, O, HB, tab, ssq_out, vstat}, c.tid);
    __syncthreads();
}

DI void convert_wT(const Ctx& c0, const float* __restrict__ W, bf16_t* __restrict__ Wt, int K, int N, const float* __restrict__ gain) {
    const Ctx c = mk(c0);
    LAS float* tile = (LAS float*)c.lds;
    const int tn = N / 64, ntile = (K / 64) * tn;
    const int r0 = c.tid >> 4, c4 = (c.tid & 15) * 4;
    float4 v[2]; float gk[2] = {1.f, 1.f};
#define CV_LOAD(IT) do { const int k0_ = ((IT) / tn) * 64, n0_ = ((IT) % tn) * 64; \
        _Pragma("unroll") for (int p = 0; p < 2; ++p) { v[p] = *(const float4*)(W + (size_t)(k0_ + r0 + 32 * p) * N + n0_ + c4); gk[p] = gain ? gain[k0_ + r0 + 32 * p] : 1.f; } } while (0)
    if (c.bid < ntile) CV_LOAD(c.bid);
    for (int it = c.bid; it < ntile; it += c.nb) {
        const int k0 = (it / tn) * 64, n0 = (it % tn) * 64;
#pragma unroll
        for (int p = 0; p < 2; ++p) {
            const int r = r0 + 32 * p;
            tile[r * 65 + c4 + 0] = v[p].x * gk[p]; tile[r * 65 + c4 + 1] = v[p].y * gk[p]; tile[r * 65 + c4 + 2] = v[p].z * gk[p]; tile[r * 65 + c4 + 3] = v[p].w * gk[p];
        }
        if (it + c.nb < ntile) CV_LOAD(it + c.nb);
        LDS_BAR();
        const int n = c.tid >> 3, kg = c.tid & 7;
        u32x4 w;
        w.x = pack2(tile[(kg * 8 + 0) * 65 + n], tile[(kg * 8 + 1) * 65 + n]);
        w.y = pack2(tile[(kg * 8 + 2) * 65 + n], tile[(kg * 8 + 3) * 65 + n]);
        w.z = pack2(tile[(kg * 8 + 4) * 65 + n], tile[(kg * 8 + 5) * 65 + n]);
        w.w = pack2(tile[(kg * 8 + 6) * 65 + n], tile[(kg * 8 + 7) * 65 + n]);
        *(u32x4*)(Wt + (size_t)(n0 + n) * K + k0 + kg * 8) = w;
        LDS_BAR();
    }
#undef CV_LOAD
    __syncthreads();
}

DI void prologue_phase(const Ctx& c0, const float* src, bf16_t* dst, float* ssqA) {
    const Ctx c = mk(c0);
    for (int rowb = c.bid * 8 + c.wave; rowb < T; rowb += 2 * c.nb * 8) {
        float4 v[2][4];
#pragma unroll
        for (int k = 0; k < 2; ++k) { const int row = rowb + k * c.nb * 8; if (row < T) {
#pragma unroll
            for (int i = 0; i < 4; ++i) v[k][i] = ((const float4*)(src + (size_t)row * DM))[c.lane + 64 * i]; } }
#pragma unroll
        for (int k = 0; k < 2; ++k) { const int row = rowb + k * c.nb * 8; if (row < T) {
            float ss = 0.f;
#pragma unroll
            for (int i = 0; i < 4; ++i) {
                u32x2 w; w.x = pack2(v[k][i].x, v[k][i].y); w.y = pack2(v[k][i].z, v[k][i].w);
                *(u32x2*)(dst + (size_t)row * DM + (c.lane + 64 * i) * 4) = w;
                const float r0 = lo_f(w.x), r1 = hi_f(w.x), r2 = lo_f(w.y), r3 = hi_f(w.y);
                ss += r0 * r0 + r1 * r1 + r2 * r2 + r3 * r3;
            }
            ss = wave_sum(ss);
            if (c.lane < 16) ssqA[row * 16 + c.lane] = (c.lane == 0) ? ss : 0.f; } }
    }
}
DI void final_norm_phase(const Ctx& c0, const bf16_t* hb, float* out, const float* __restrict__ g, const float* ssq) {
    const Ctx c = mk(c0);
    constexpr int NCH = T * DM / 8, STRIDE = 256 * NTHR;
    for (int i0 = c.bid * NTHR + c.tid; i0 < NCH; i0 += 4 * c.nb * NTHR) {
        const int gi = ((c.bid * NTHR + c.tid) & 127) * 2;
        const float4 g0 = ((const float4*)g)[gi], g1 = ((const float4*)g)[gi + 1];
        u32x4 w[4]; f32x4 sa[4], sb[4], sc[4], sd[4];
#pragma unroll
        for (int k = 0; k < 4; ++k) { const int i = i0 + k * c.nb * NTHR; if (i < NCH) { w[k] = ((const u32x4*)hb)[i]; const f32x4* sp = (const f32x4*)(ssq + (i >> 7) * 16); sa[k] = sp[0]; sb[k] = sp[1]; sc[k] = sp[2]; sd[k] = sp[3]; } }
#pragma unroll
        for (int k = 0; k < 4; ++k) { const int i = i0 + k * c.nb * NTHR; if (i < NCH) {
            const f32x4 s4 = (sa[k] + sb[k]) + (sc[k] + sd[k]);
            const float r = rsqrtf((s4[0] + s4[1] + s4[2] + s4[3]) * (1.0f / DM) + 1e-6f);
            float4 o0, o1;
            o0.x = lo_f(w[k].x) * r * g0.x; o0.y = hi_f(w[k].x) * r * g0.y; o0.z = lo_f(w[k].y) * r * g0.z; o0.w = hi_f(w[k].y) * r * g0.w;
            o1.x = lo_f(w[k].z) * r * g1.x; o1.y = hi_f(w[k].z) * r * g1.y; o1.z = lo_f(w[k].w) * r * g1.z; o1.w = hi_f(w[k].w) * r * g1.w;
            ((float4*)out)[2 * i] = o0; ((float4*)out)[2 * i + 1] = o1; } }
    }
    (void)STRIDE;
}

DI void gmlp_stats_phase(const Ctx& c0, const bf16_t* big, float* stats) {
    const Ctx c = mk(c0);
    for (int row = c.bid * 8 + c.wave; row < T; row += c.nb * 8) {
        const u32x4* p = (const u32x4*)(big + (size_t)row * 4096 + 2048);
        float x[32]; float s = 0.f;
#pragma unroll
        for (int i = 0; i < 4; ++i) { const u32x4 w = p[c.lane + 64 * i];
            x[i * 8 + 0] = lo_f(w.x); x[i * 8 + 1] = hi_f(w.x); x[i * 8 + 2] = lo_f(w.y); x[i * 8 + 3] = hi_f(w.y);
            x[i * 8 + 4] = lo_f(w.z); x[i * 8 + 5] = hi_f(w.z); x[i * 8 + 6] = lo_f(w.w); x[i * 8 + 7] = hi_f(w.w); }
#pragma unroll
        for (int i = 0; i < 32; ++i) s += x[i];
        const float mean = wave_sum(s) * (1.0f / 2048.f);
        float q = 0.f;
#pragma unroll
        for (int i = 0; i < 32; ++i) { const float d = x[i] - mean; q += d * d; }
        q = wave_sum(q);
        if (c.lane == 0) { stats[2 * row] = mean; stats[2 * row + 1] = rsqrtf(q * (1.0f / 2048.f) + 1e-6f); }
    }
}
DI void gmlp_spatial_phase(const Ctx& c0, bf16_t* big, const float* vstat, const float* __restrict__ ws_, const float* __restrict__ bs_, const float* __restrict__ lng, const float* __restrict__ lnb) {
    const Ctx c = mk(c0);
    constexpr int P = 272;
    constexpr unsigned WS_O = 0, VS_O = 128 * P, ST_O = 256 * P;
    LAS float* ST = (LAS float*)(c.lds + ST_O);
    const int lane = c.lane, w = c.wave;
    int g_loaded = -1;
    for (int it = c.bid; it < 2048; it += c.nb) {
        const int chunk = it >> 4, g = it & 15;
        const int sr = c.tid >> 2, sq = c.tid & 3;
        const f32x4* stp = (const f32x4*)(vstat + ((size_t)(chunk * 128 + sr) * 32 + sq * 8) * 2);
        const f32x4 a0 = stp[0], a1 = stp[1], a2 = stp[2], a3 = stp[3];
        u32x4 vraw[4];
#pragma unroll
        for (int i = 0; i < 4; ++i) { const int idx = c.tid + 512 * i, s = idx >> 4, d8 = (idx & 15) * 8;
            vraw[i] = *(const u32x4*)(big + (size_t)(chunk * 128 + s) * 4096 + 2048 + g * 128 + d8); }
        const int t0 = 16 * w, t = t0 + (lane & 15), row = chunk * 128 + t, g4 = lane >> 4;
        u32x2 uraw[8];
#pragma unroll
        for (int dt = 0; dt < 8; ++dt) uraw[dt] = *(const u32x2*)(big + (size_t)row * 4096 + g * 128 + 16 * dt + 4 * g4);
        const float bsv = bs_[g * 128 + t];
        const int lcol = g * 128 + (c.tid & 15) * 8;
        const float4 g0 = *(const float4*)(lng + lcol), g1 = *(const float4*)(lng + lcol + 4), b0 = *(const float4*)(lnb + lcol), b1 = *(const float4*)(lnb + lcol + 4);
        if (g != g_loaded) {
            const float* Wg = ws_ + (size_t)g * 128 * 128;
            float4 wv8[8];
#pragma unroll
            for (int i = 0; i < 8; ++i) { const int idx = c.tid + 512 * i; wv8[i] = *(const float4*)(Wg + (idx >> 5) * 128 + (idx & 31) * 4); }
#pragma unroll
            for (int i = 0; i < 8; ++i) {
                const int idx = c.tid + 512 * i, tt = idx >> 5, s4 = (idx & 31) * 4;
                const float4 v = wv8[i];
                u32x2 o; o.x = pack2(s4 + 0 <= tt ? v.x : 0.f, s4 + 1 <= tt ? v.y : 0.f); o.y = pack2(s4 + 2 <= tt ? v.z : 0.f, s4 + 3 <= tt ? v.w : 0.f);
                *(LAS u32x2*)(c.lds + WS_O + tt * P + s4 * 2) = o;
            }
            g_loaded = g;
        }
        {
            float s1 = (a0[0] + a0[2]) + (a1[0] + a1[2]) + (a2[0] + a2[2]) + (a3[0] + a3[2]);
            float s2 = (a0[1] + a0[3]) + (a1[1] + a1[3]) + (a2[1] + a2[3]) + (a3[1] + a3[3]);
            s1 += __shfl_xor(s1, 1, 64); s1 += __shfl_xor(s1, 2, 64); s2 += __shfl_xor(s2, 1, 64); s2 += __shfl_xor(s2, 2, 64);
            const float mean = s1 * (1.0f / 2048.f), var = fmaxf(s2 * (1.0f / 2048.f) - mean * mean, 0.f);
            if (sq == 0) { ST[2 * sr] = mean; ST[2 * sr + 1] = rsqrtf(var + 1e-6f); }
        }
        __syncthreads();
#pragma unroll
        for (int i = 0; i < 4; ++i) {
            const int idx = c.tid + 512 * i, s = idx >> 4, d8 = (idx & 15) * 8;
            const int col = g * 128 + d8;
            const u32x4 raw = vraw[i];
            const float mean = ST[2 * s], rstd = ST[2 * s + 1];
            u32x4 o;
            o.x = pack2((lo_f(raw.x) - mean) * rstd * g0.x + b0.x, (hi_f(raw.x) - mean) * rstd * g0.y + b0.y);
            o.y = pack2((lo_f(raw.y) - mean) * rstd * g0.z + b0.z, (hi_f(raw.y) - mean) * rstd * g0.w + b0.w);
            o.z = pack2((lo_f(raw.z) - mean) * rstd * g1.x + b1.x, (hi_f(raw.z) - mean) * rstd * g1.y + b1.y);
            o.w = pack2((lo_f(raw.w) - mean) * rstd * g1.z + b1.z, (hi_f(raw.w) - mean) * rstd * g1.w + b1.w);
            *(LAS u32x4*)(c.lds + VS_O + s * P + d8 * 2) = o;
        }
        __syncthreads();
        f32x4 acc[8];
#pragma unroll
        for (int dt = 0; dt < 8; ++dt) acc[dt] = (f32x4){0.f, 0.f, 0.f, 0.f};
        for (int s0 = 0; s0 <= t0 + 15; s0 += 32) {
            const bf16x8 y = row_load(c.lds, WS_O, P, t0, s0, lane);
            const unsigned ta = tr_addr(c.ldsb + VS_O, P, s0, 0, lane);
#pragma unroll
            for (int dq = 0; dq < 2; ++dq) { bf16x8 x[4]; tr_load4(x, ta + 128 * dq, ta + 128 * dq + 32, ta + 128 * dq + 64, ta + 128 * dq + 96, P);
#pragma unroll
                for (int k = 0; k < 4; ++k) acc[4 * dq + k] = mfma16(x[k], y, acc[4 * dq + k]); }
        }
#pragma unroll
        for (int dt = 0; dt < 8; ++dt) {
            bf16_t* p = big + (size_t)row * 4096 + g * 128 + 16 * dt + 4 * g4;
            const u32x2 u = uraw[dt];
            u32x2 o; o.x = pack2(lo_f(u.x) * (acc[dt][0] + bsv), hi_f(u.x) * (acc[dt][1] + bsv)); o.y = pack2(lo_f(u.y) * (acc[dt][2] + bsv), hi_f(u.y) * (acc[dt][3] + bsv));
            *(u32x2*)p = o;
        }
        __syncthreads();
    }
}

DI void hgrn_local_phase(const Ctx& c0, bf16_t* big, bf16_t* states, float* dec, const float* __restrict__ lb_logits, int layer) {
    const Ctx c = mk(c0);
    constexpr int P = 272, PP = 144;
    constexpr int BP = 136;
    constexpr unsigned BC_O = 0, TOT_O = 64 * BP * 4, QM_O = TOT_O + 2048, KM_O = QM_O + 64 * P, KH_O = KM_O + 64 * P, IM_O = KH_O + 64 * P, PM_O = IM_O + 64 * P;
    LAS float* BC = (LAS float*)(c.lds + BC_O); LAS float* TOT = (LAS float*)(c.lds + TOT_O);
    LAS float* LBT = (LAS float*)(c.lds + PM_O + 64 * PP);
    const int lane = c.lane, w = c.wave, tid = c.tid;
    const int row = tid >> 3, c16 = (tid & 7) * 16;
    u32x4 qa, qb, ia, ib, fa, fb; float lb[16];
#define HL_LOAD(IT) do { const int bh_ = (IT) >> 7, ch_ = (IT) & 127, h_ = bh_ & 7; \
        const bf16_t* p_ = big + (size_t)((bh_ >> 3) * SEQ + ch_ * 64 + row) * 4096 + h_ * 128 + c16; \
        qa = *(const u32x4*)(p_); qb = *(const u32x4*)(p_ + 8); ia = *(const u32x4*)(p_ + 2048); ib = *(const u32x4*)(p_ + 2048 + 8); fa = *(const u32x4*)(p_ + 1024); fb = *(const u32x4*)(p_ + 1024 + 8); \
        _Pragma("unroll") for (int j = 0; j < 16; j += 4) { const f32x4 t4_ = *(const LAS f32x4*)(LBT + h_ * 128 + c16 + j); lb[j] = t4_[0]; lb[j + 1] = t4_[1]; lb[j + 2] = t4_[2]; lb[j + 3] = t4_[3]; } } while (0)
#pragma unroll
    for (int k = 0; k < 2; ++k) { const int d = tid + 512 * k;
        const float l0 = lb_logits[d], l1 = lb_logits[1024 + d], l2 = lb_logits[2048 + d], l3 = lb_logits[3072 + d];
        const float mx = fmaxf(fmaxf(l0, l1), fmaxf(l2, l3));
        const float e0 = __expf(l0 - mx), e1 = __expf(l1 - mx), e2 = __expf(l2 - mx), e3 = __expf(l3 - mx);
        float num = 0.f; if (layer >= 1) num += e1; if (layer >= 2) num += e2; if (layer >= 3) num += e3;
        LBT[d] = num / (e0 + e1 + e2 + e3); }
    __syncthreads();
    if (c.bid < 2048) HL_LOAD(c.bid);
    for (int it = c.bid; it < 2048; it += c.nb) {
        const int bh = it >> 7, ch = it & 127, b = bh >> 3, h = bh & 7;
        const int r0 = b * SEQ + ch * 64;
        bf16_t* prow = big + (size_t)(r0 + row) * 4096 + h * 128 + c16;
        float xf[16];
        { const u32x4 a = fa, bq = fb;
          xf[0] = lo_f(a.x); xf[1] = hi_f(a.x); xf[2] = lo_f(a.y); xf[3] = hi_f(a.y); xf[4] = lo_f(a.z); xf[5] = hi_f(a.z); xf[6] = lo_f(a.w); xf[7] = hi_f(a.w);
          xf[8] = lo_f(bq.x); xf[9] = hi_f(bq.x); xf[10] = lo_f(bq.y); xf[11] = hi_f(bq.y); xf[12] = lo_f(bq.z); xf[13] = hi_f(bq.z); xf[14] = lo_f(bq.w); xf[15] = hi_f(bq.w); }
#pragma unroll
        for (int j = 0; j < 16; ++j) { const float f = lb[j] + (1.0f - lb[j]) * sigmoidf_(xf[j]); BC[row * BP + j * 8 + (tid & 7)] = __logf(f); xf[j] = 1.0f - f; }
        __syncthreads();
        {
            const int d = tid & 127, seg = tid >> 7;
            float pre[16]; float run = 0.f;
#pragma unroll
            for (int j = 0; j < 16; ++j) { run += BC[(seg * 16 + j) * BP + d]; pre[j] = run; }
            TOT[seg * 128 + d] = run;
            __syncthreads();
            float off = 0.f;
            for (int s = 0; s < seg; ++s) off += TOT[s * 128 + d];
#pragma unroll
            for (int j = 0; j < 16; ++j) BC[(seg * 16 + j) * BP + d] = pre[j] + off;
        }
        __syncthreads();
        {
            float qv[16], iv_dummy;
            (void)iv_dummy;
            qv[0] = lo_f(qa.x); qv[1] = hi_f(qa.x); qv[2] = lo_f(qa.y); qv[3] = hi_f(qa.y); qv[4] = lo_f(qa.z); qv[5] = hi_f(qa.z); qv[6] = lo_f(qa.w); qv[7] = hi_f(qa.w);
            qv[8] = lo_f(qb.x); qv[9] = hi_f(qb.x); qv[10] = lo_f(qb.y); qv[11] = hi_f(qb.y); qv[12] = lo_f(qb.z); qv[13] = hi_f(qb.z); qv[14] = lo_f(qb.w); qv[15] = hi_f(qb.w);
            unsigned qm[8], km[8], kh[8], qi[8];
#pragma unroll
            for (int j = 0; j < 16; j += 2) {
                float o[2][4];
#pragma unroll
                for (int e = 0; e < 2; ++e) {
                    const int d = (j + e) * 8 + (tid & 7);
                    const float bc = BC[row * BP + d], bm = BC[31 * BP + d], bl = BC[63 * BP + d];
                    const float qs = siluf_(qv[j + e]);
                    const float kk = xf[j + e];
                    o[e][0] = qs * __expf(bc - bm); o[e][1] = kk * __expf(bm - bc); o[e][2] = kk * __expf(bl - bc); o[e][3] = qs * __expf(bc);
                }
                qm[j >> 1] = pack2(o[0][0], o[1][0]); km[j >> 1] = pack2(o[0][1], o[1][1]); kh[j >> 1] = pack2(o[0][2], o[1][2]); qi[j >> 1] = pack2(o[0][3], o[1][3]);
            }
            const unsigned off = row * P + c16 * 2;
            *(LAS u32x4*)(c.lds + QM_O + off) = (u32x4){qm[0], qm[1], qm[2], qm[3]}; *(LAS u32x4*)(c.lds + QM_O + off + 16) = (u32x4){qm[4], qm[5], qm[6], qm[7]};
            *(LAS u32x4*)(c.lds + KM_O + off) = (u32x4){km[0], km[1], km[2], km[3]}; *(LAS u32x4*)(c.lds + KM_O + off + 16) = (u32x4){km[4], km[5], km[6], km[7]};
            *(LAS u32x4*)(c.lds + KH_O + off) = (u32x4){kh[0], kh[1], kh[2], kh[3]}; *(LAS u32x4*)(c.lds + KH_O + off + 16) = (u32x4){kh[4], kh[5], kh[6], kh[7]};
            *(LAS u32x4*)(c.lds + IM_O + off) = ia; *(LAS u32x4*)(c.lds + IM_O + off + 16) = ib;
            *(u32x4*)(prow) = (u32x4){qi[0], qi[1], qi[2], qi[3]}; *(u32x4*)(prow + 8) = (u32x4){qi[4], qi[5], qi[6], qi[7]};
            if (tid < 128) dec[(size_t)it * 128 + tid] = __expf(BC[63 * BP + (tid & 15) * 8 + (tid >> 4)]);
        }
        __syncthreads();
        if (it + c.nb < 2048) HL_LOAD(it + c.nb);
        {
            const int ti = w >> 1;
#pragma unroll
            for (int k2 = 0; k2 < 2; ++k2) {
                const int si = 2 * (w & 1) + k2;
                f32x4 acc = (f32x4){0.f, 0.f, 0.f, 0.f};
                if (si <= ti) {
#pragma unroll
                    for (int d0 = 0; d0 < 128; d0 += 32) { const bf16x8 x = row_load(c.lds, QM_O, P, 16 * ti, d0, lane), y = row_load(c.lds, KM_O, P, 16 * si, d0, lane); acc = mfma16(x, y, acc); }
                }
                const int s = 16 * si + (lane & 15);
#pragma unroll
                for (int e = 0; e < 4; ++e) { const int t = 16 * ti + 4 * (lane >> 4) + e;
                    *(LAS bf16_t*)(c.lds + PM_O + t * PP + s * 2) = (bf16_t)((si <= ti && s <= t) ? f2bf(acc[e]) : 0u); }
            }
        }
        __syncthreads();
        {
            const int t0 = 16 * (w >> 1);
            const bf16x8 y0 = row_load(c.lds, PM_O, PP, t0, 0, lane), y1 = row_load(c.lds, PM_O, PP, t0, 32, lane);
            const int t = t0 + (lane & 15);
            bf16x8 xi0[4], xi1[4];
            { const unsigned ta = tr_addr(c.ldsb + IM_O, P, 0, 64 * (w & 1), lane); tr_load4(xi0, ta, ta + 32, ta + 64, ta + 96, P); tr_load4(xi1, ta + 32 * P, ta + 32 * P + 32, ta + 32 * P + 64, ta + 32 * P + 96, P); }
#pragma unroll
            for (int k4 = 0; k4 < 4; ++k4) {
                const int v0 = 16 * (4 * (w & 1) + k4);
                f32x4 acc = (f32x4){0.f, 0.f, 0.f, 0.f};
                acc = mfma16(xi0[k4], y0, acc);
                acc = mfma16(xi1[k4], y1, acc);
                u32x2 o; o.x = pack2(acc[0], acc[1]); o.y = pack2(acc[2], acc[3]);
                *(u32x2*)(big + (size_t)(r0 + t) * 4096 + 1024 + h * 128 + v0 + 4 * (lane >> 4)) = o;
            }
        }
        {
            const int v0 = 16 * w;
            const bf16x8 x0 = tr_load(c.ldsb + IM_O, P, 0, v0, lane), x1 = tr_load(c.ldsb + IM_O, P, 32, v0, lane);
            bf16_t* Sg = states + (size_t)it * 16384;
            const unsigned tk = tr_addr(c.ldsb + KH_O, P, 0, 0, lane);
#pragma unroll
            for (int dq = 0; dq < 2; ++dq) {
                bf16x8 ya[4], yb[4];
                tr_load4(ya, tk + 128 * dq, tk + 128 * dq + 32, tk + 128 * dq + 64, tk + 128 * dq + 96, P);
                tr_load4(yb, tk + 32 * P + 128 * dq, tk + 32 * P + 128 * dq + 32, tk + 32 * P + 128 * dq + 64, tk + 32 * P + 128 * dq + 96, P);
#pragma unroll
                for (int k = 0; k < 4; ++k) { const int dt = 4 * dq + k;
                    f32x4 acc = (f32x4){0.f, 0.f, 0.f, 0.f};
                    acc = mfma16(x0, ya[k], acc);
                    acc = mfma16(x1, yb[k], acc);
                    u32x2 o; o.x = pack2(acc[0], acc[1]); o.y = pack2(acc[2], acc[3]);
                    *(u32x2*)(Sg + (16 * dt + (lane & 15)) * 128 + v0 + 4 * (lane >> 4)) = o; }
            }
        }
        LDS_BAR();
    }
#undef HL_LOAD
}
DI void hgrn_scan_phase(const Ctx& c0, bf16_t* states, const float* dec) {
    const Ctx c = mk(c0);
    for (int gid = c.bid * NTHR + c.tid; gid < 16 * 8192; gid += c.nb * NTHR) {
        const int bh = gid >> 13, pr = gid & 8191, d = pr >> 6;
        unsigned* p = (unsigned*)(states + (size_t)bh * 128 * 16384) + pr;
        const float* dp = dec + (size_t)bh * 128 * 128 + d;
        float s0 = 0.f, s1 = 0.f;
        for (int cb = 0; cb < 128; cb += 4) {
            unsigned dv[4]; float dc[4];
#pragma unroll
            for (int j = 0; j < 4; ++j) { dv[j] = p[(size_t)(cb + j) * 8192]; dc[j] = dp[(cb + j) * 128]; }
#pragma unroll
            for (int j = 0; j < 4; ++j) { const unsigned o = pack2(s0, s1); s0 = dc[j] * s0 + lo_f(dv[j]); s1 = dc[j] * s1 + hi_f(dv[j]); dv[j] = o; }
#pragma unroll
            for (int j = 0; j < 4; ++j) p[(size_t)(cb + j) * 8192] = dv[j];
        }
    }
}
DI void hgrn_out_phase(const Ctx& c0, bf16_t* big, const bf16_t* states, const float* __restrict__ norm_g) {
    const Ctx c = mk(c0);
    constexpr int P = 272;
    constexpr unsigned SM_O = 0, QI_O = 128 * P, RED_O = QI_O + 64 * P;
    LAS float* RED = (LAS float*)(c.lds + RED_O);
    const int lane = c.lane, w = c.wave, tid = c.tid;
    for (int it = c.bid; it < 2048; it += c.nb) {
        const int bh = it >> 7, ch = it & 127, b = bh >> 3, h = bh & 7;
        const int r0 = b * SEQ + ch * 64;
        const bf16_t* Sg = states + (size_t)it * 16384;
        u32x4 sld[4], qld[2];
#pragma unroll
        for (int i = 0; i < 4; ++i) { const int idx = tid + 512 * i; sld[i] = *(const u32x4*)(Sg + (idx >> 4) * 128 + (idx & 15) * 8); }
#pragma unroll
        for (int i = 0; i < 2; ++i) { const int idx = tid + 512 * i; qld[i] = *(const u32x4*)(big + (size_t)(r0 + (idx >> 4)) * 4096 + h * 128 + (idx & 15) * 8); }
        const int t0 = 16 * (w & 3), vh = w >> 2;
        const int t = t0 + (lane & 15), g4 = lane >> 4;
        bf16_t* prow = big + (size_t)(r0 + t) * 4096 + h * 128;
        u32x2 oiv[4], gvv[4];
#pragma unroll
        for (int k4 = 0; k4 < 4; ++k4) { const int v = 16 * (4 * vh + k4) + 4 * g4; oiv[k4] = *(const u32x2*)(prow + 1024 + v); gvv[k4] = *(const u32x2*)(prow + 3072 + v); }
        float4 ngv[4];
#pragma unroll
        for (int k4 = 0; k4 < 4; ++k4) ngv[k4] = *(const float4*)(norm_g + h * 128 + 16 * (4 * vh + k4) + 4 * g4);
#pragma unroll
        for (int i = 0; i < 4; ++i) { const int idx = tid + 512 * i; *(LAS u32x4*)(c.lds + SM_O + (idx >> 4) * P + (idx & 15) * 16) = sld[i]; }
#pragma unroll
        for (int i = 0; i < 2; ++i) { const int idx = tid + 512 * i; *(LAS u32x4*)(c.lds + QI_O + (idx >> 4) * P + (idx & 15) * 16) = qld[i]; }
        __syncthreads();
        f32x4 acc[4];
#pragma unroll
        for (int k4 = 0; k4 < 4; ++k4) acc[k4] = (f32x4){0.f, 0.f, 0.f, 0.f};
#pragma unroll
        for (int d0 = 0; d0 < 128; d0 += 32) {
            const bf16x8 y = row_load(c.lds, QI_O, P, t0, d0, lane);
            bf16x8 x[4]; { const unsigned ta = tr_addr(c.ldsb + SM_O, P, d0, 64 * vh, lane); tr_load4(x, ta, ta + 32, ta + 64, ta + 96, P); }
#pragma unroll
            for (int k4 = 0; k4 < 4; ++k4) acc[k4] = mfma16(x[k4], y, acc[k4]);
        }
        float ss = 0.f;
#pragma unroll
        for (int k4 = 0; k4 < 4; ++k4) {
            const int v = 16 * (4 * vh + k4) + 4 * g4;
            const u32x2 oi = oiv[k4];
            acc[k4][0] += lo_f(oi.x); acc[k4][1] += hi_f(oi.x); acc[k4][2] += lo_f(oi.y); acc[k4][3] += hi_f(oi.y);
            ss += acc[k4][0] * acc[k4][0] + acc[k4][1] * acc[k4][1] + acc[k4][2] * acc[k4][2] + acc[k4][3] * acc[k4][3];
        }
        ss += __shfl_xor(ss, 16, 64); ss += __shfl_xor(ss, 32, 64);
        if (g4 == 0) RED[t * 2 + vh] = ss;
        __syncthreads();
        const float rstd = rsqrtf((RED[t * 2] + RED[t * 2 + 1]) * (1.0f / 128.f) + 1e-6f);
#pragma unroll
        for (int k4 = 0; k4 < 4; ++k4) {
            const int v = 16 * (4 * vh + k4) + 4 * g4;
            const u32x2 gv = gvv[k4];
            const float4 ng = ngv[k4];
            u32x2 o;
            o.x = pack2(acc[k4][0] * rstd * ng.x * siluf_(lo_f(gv.x)), acc[k4][1] * rstd * ng.y * siluf_(hi_f(gv.x)));
            o.y = pack2(acc[k4][2] * rstd * ng.z * siluf_(lo_f(gv.y)), acc[k4][3] * rstd * ng.w * siluf_(hi_f(gv.y)));
            *(u32x2*)(prow + 3072 + v) = o;
        }
        __syncthreads();
    }
}

DI void mlstm_conv_phase(const Ctx& cx, const bf16_t* big, bf16_t* CA, float* gates, const float* __restrict__ conv_w, const float* __restrict__ conv_b,
                         const float* __restrict__ wq, const float* __restrict__ wk, const float* __restrict__ wv, const float* __restrict__ wg, const float* __restrict__ bg) {
    const Ctx c = mk(cx);
    LAS float* GS = (LAS float*)c.lds;
    const int tid = c.tid, lane = c.lane, w = c.wave;
    const int c0 = 4 * tid;
    float cw[4][4], cb[4], wca[4][8], wvv[4][8];
#pragma unroll
    for (int j = 0; j < 4; ++j) { const float4 v = *(const float4*)(conv_w + j * 2048 + c0); cw[j][0] = v.x; cw[j][1] = v.y; cw[j][2] = v.z; cw[j][3] = v.w; }
    { const float4 v = *(const float4*)(conv_b + c0); cb[0] = v.x; cb[1] = v.y; cb[2] = v.z; cb[3] = v.w; }
#pragma unroll
    for (int d = 0; d < 4; ++d)
#pragma unroll
        for (int gi = 0; gi < 8; ++gi) { float a = 0.f, bsum = 0.f;
#pragma unroll
            for (int e = 0; e < 4; ++e) {
                a += wq[tid * 16 + d * 4 + e] * wg[(size_t)(c0 + e) * 8 + gi] + wk[tid * 16 + d * 4 + e] * wg[(size_t)(2048 + c0 + e) * 8 + gi];
                bsum += wv[tid * 16 + d * 4 + e] * wg[(size_t)(4096 + c0 + e) * 8 + gi]; }
            wca[d][gi] = a; wvv[d][gi] = bsum; }
    for (int it = c.bid; it < T / 16; it += c.nb) {
        const int r0 = it * 16;
        const bool first = (r0 % SEQ) == 0;
        u32x2 xs[19];
#pragma unroll
        for (int j = 0; j < 3; ++j) xs[j] = first ? (u32x2){0u, 0u} : *(const u32x2*)(big + (size_t)(r0 - 3 + j) * 4096 + c0);
#pragma unroll
        for (int j = 0; j < 16; ++j) xs[3 + j] = *(const u32x2*)(big + (size_t)(r0 + j) * 4096 + c0);
#pragma unroll
        for (int tt = 0; tt < 16; ++tt) {
            float x[4][4];
#pragma unroll
            for (int j = 0; j < 4; ++j) { x[j][0] = lo_f(xs[tt + j].x); x[j][1] = hi_f(xs[tt + j].x); x[j][2] = lo_f(xs[tt + j].y); x[j][3] = hi_f(xs[tt + j].y); }
            float ca[4];
#pragma unroll
            for (int e = 0; e < 4; ++e) ca[e] = siluf_(cb[e] + cw[0][e] * x[0][e] + cw[1][e] * x[1][e] + cw[2][e] * x[2][e] + cw[3][e] * x[3][e]);
            u32x2 o; o.x = pack2(ca[0], ca[1]); o.y = pack2(ca[2], ca[3]);
            *(u32x2*)(CA + (size_t)(r0 + tt) * 2048 + c0) = o;
            float p[8];
#pragma unroll
            for (int gi = 0; gi < 8; ++gi) { float a = 0.f;
#pragma unroll
                for (int e = 0; e < 4; ++e) a += ca[e] * wca[e][gi] + x[3][e] * wvv[e][gi];
                p[gi] = a; }
            const bool h1 = (lane & 32) != 0, h2 = (lane & 16) != 0, h3 = (lane & 8) != 0;
            float q4[4], r2[2];
#pragma unroll
            for (int j = 0; j < 4; ++j) { const float send = h1 ? p[j] : p[j + 4], keep = h1 ? p[j + 4] : p[j]; q4[j] = keep + __shfl_xor(send, 32, 64); }
#pragma unroll
            for (int j = 0; j < 2; ++j) { const float send = h2 ? q4[j] : q4[j + 2], keep = h2 ? q4[j + 2] : q4[j]; r2[j] = keep + __shfl_xor(send, 16, 64); }
            float s;
            { const float send = h3 ? r2[0] : r2[1], keep = h3 ? r2[1] : r2[0]; s = keep + __shfl_xor(send, 8, 64); }
            s += __shfl_xor(s, 4, 64); s += __shfl_xor(s, 2, 64); s += __shfl_xor(s, 1, 64);
            if ((lane & 7) == 0) GS[(w * 16 + tt) * 8 + (lane >> 3)] = s;
        }
        __syncthreads();
        if (tid < 128) { float a = bg[tid & 7];
#pragma unroll
            for (int ww = 0; ww < 8; ++ww) a += GS[ww * 128 + tid];
            gates[(size_t)r0 * 8 + tid] = a; }
        __syncthreads();
    }
}
struct QKW { float k[16]; };
DI void load_qkw(QKW& W, const float* __restrict__ wq, const float* __restrict__ wk, int h, int tid) {
    const int nb0 = h * 128 + (tid & 127);
#pragma unroll
    for (int cc = 0; cc < 4; ++cc)
#pragma unroll
        for (int d = 0; d < 4; ++d) { float a = 0.f;
#pragma unroll
            for (int e = 0; e < 4; ++e) a += wk[nb0 * 16 + cc * 4 + e] * wq[nb0 * 16 + d * 4 + e];
            W.k[cc * 4 + d] = a * 0.04419417382415922f; }
}
DI void qk_to_lds(LAS unsigned char* lds, unsigned q_o, unsigned k_o, const QKW& W, const u32x2 raw, int t, int cb) {
    const float x[4] = {lo_f(raw.x), hi_f(raw.x), lo_f(raw.y), hi_f(raw.y)};
    float k[4];
#pragma unroll
    for (int e = 0; e < 4; ++e) { float bsum = 0.f;
#pragma unroll
        for (int d = 0; d < 4; ++d) bsum += x[d] * W.k[d * 4 + e];
        k[e] = bsum; }
    const unsigned off = t * 1040 + cb * 8;
    *(LAS u32x2*)(lds + q_o + off) = raw;
    *(LAS u32x2*)(lds + k_o + off) = (u32x2){pack2(k[0], k[1]), pack2(k[2], k[3])};
}
DI void mlstm_smat_phase(const Ctx& c0, const bf16_t* CA, const float* gates, float* scal, bf16_t* Sg, const float* __restrict__ wq, const float* __restrict__ wk) {
    const Ctx c = mk(c0);
    constexpr int P = 1040;
    constexpr unsigned Q_O = 0, K_O = 64 * P, SC_O = 128 * P;
    LAS float* SC = (LAS float*)(c.lds + SC_O);
    const int lane = c.lane, w = c.wave, tid = c.tid;
    for (int it = c.bid; it < 1024; it += c.nb) {
        const int bh = it >> 7, ch = it & 127, b = bh >> 2, h = bh & 3;
        const int r0 = b * SEQ + ch * 64;
        if (w == 0) {
            const float gi = gates[(size_t)(r0 + lane) * 8 + h], gf = gates[(size_t)(r0 + lane) * 8 + 4 + h];
            const float lf = fminf(gf, 0.f) - log1pf(__expf(-fabsf(gf)));
            float a = lf;
#pragma unroll
            for (int o = 1; o < 64; o <<= 1) { const float v = __shfl_up(a, o, 64); if (lane >= o) a += v; }
            float pm = gi - a;
#pragma unroll
            for (int o = 1; o < 64; o <<= 1) { const float v = __shfl_up(pm, o, 64); if (lane >= o) pm = fmaxf(pm, v); }
            const float mloc = a + pm;
            const float alast = __shfl(a, 63, 64);
            const float gmax = wave_max(alast - a + gi);
            SC[lane] = a; SC[64 + lane] = gi; SC[128 + lane] = mloc;
            float* sp = scal + (size_t)it * 256;
            sp[lane] = a; sp[64 + lane] = gi; sp[128 + lane] = mloc; sp[192 + lane] = (lane == 0) ? gmax : alast;
        }
        QKW W; load_qkw(W, wq, wk, h, tid);
        {
            const int cb = tid & 127, tb = tid >> 7;
            u32x2 raw[16];
#pragma unroll
            for (int i = 0; i < 16; ++i) raw[i] = *(const u32x2*)(CA + (size_t)(r0 + tb + 4 * i) * 2048 + h * 512 + cb * 4);
#pragma unroll
            for (int i = 0; i < 16; ++i) qk_to_lds(c.lds, Q_O, K_O, W, raw[i], tb + 4 * i, cb);
        }
        __syncthreads();
        const int ti = w >> 1;
        bf16_t* So = Sg + (size_t)it * 4096;
#pragma unroll
        for (int k2 = 0; k2 < 2; ++k2) {
            const int si = 2 * (w & 1) + k2;
            f32x4 acc = (f32x4){0.f, 0.f, 0.f, 0.f};
            if (si <= ti) {
#pragma unroll 4
                for (int d0 = 0; d0 < 512; d0 += 32) { const bf16x8 x = row_load(c.lds, K_O, P, 16 * si, d0, lane), y = row_load(c.lds, Q_O, P, 16 * ti, d0, lane); acc = mfma16(x, y, acc); }
            }
            const int t = 16 * ti + (lane & 15);
            const float at = SC[t], mt = SC[128 + t];
            float o[4];
#pragma unroll
            for (int e = 0; e < 4; ++e) { const int s = 16 * si + 4 * (lane >> 4) + e;
                o[e] = (si <= ti && s <= t) ? acc[e] * __expf(at - SC[s] + SC[64 + s] - mt) : 0.f; }
            u32x2 ov; ov.x = pack2(o[0], o[1]); ov.y = pack2(o[2], o[3]);
            *(u32x2*)(So + t * 64 + 16 * si + 4 * (lane >> 4)) = ov;
        }
        __syncthreads();
    }
}
DI void mlstm_scan_phase(const Ctx& c0, bf16_t* big, const bf16_t* CA, const float* scal, const bf16_t* Sg, const float* __restrict__ wq, const float* __restrict__ wk, const float* __restrict__ wv) {
    const Ctx c = mk(c0);
    constexpr int PS = 144, PV = 80, PT = 136;
    constexpr unsigned PART_O = 0, SS_O = 69632, VA_O = SS_O + 64 * PS, VHT_O = VA_O + 64 * PV, SCL_O = VHT_O + 32 * PT, QT_O = SCL_O + 2048;
    LAS float* PART = (LAS float*)(c.lds + PART_O);
    LAS float* SCL = (LAS float*)(c.lds + SCL_O);
    const int lane = c.lane, w = c.wave, tid = c.tid, g4 = lane >> 4, l15 = lane & 15;
    for (int wi_ = c.bid; wi_ < 256; wi_ += c.nb) {
        const int bh = wi_ & 7, sl = wi_ >> 3, b = bh >> 2, h = bh & 3;
        const int vcol = h * 512 + sl * 16;
        bf16x8 mfr[4];
        {
            float4 wkr[4][4], wqr[4];
#pragma unroll
            for (int i4 = 0; i4 < 4; ++i4) { const int d = 64 * w + 16 * i4 + l15, nbk = (h * 512 + d) >> 2;
#pragma unroll
                for (int cc = 0; cc < 4; ++cc) wkr[i4][cc] = *(const float4*)(wk + nbk * 16 + cc * 4);
                wqr[i4] = *(const float4*)(wq + nbk * 16 + (d & 3) * 4); }
#pragma unroll
            for (int i4 = 0; i4 < 4; ++i4) {
                const int d = 64 * w + 16 * i4 + l15, cbase = 64 * w + 32 * (i4 >> 1);
                float m4[4];
#pragma unroll
                for (int cc = 0; cc < 4; ++cc) m4[cc] = 0.04419417382415922f * (wkr[i4][cc].x * wqr[i4].x + wkr[i4][cc].y * wqr[i4].y + wkr[i4][cc].z * wqr[i4].z + wkr[i4][cc].w * wqr[i4].w);
#pragma unroll
                for (int jj = 0; jj < 8; ++jj) {
                    const int cch = cbase + 16 * (jj >> 2) + 4 * g4 + (jj & 3);
                    mfr[i4][jj] = (short)f2bf(((cch >> 2) == (d >> 2)) ? m4[jj & 3] : 0.f);
                }
            }
        }
        LAS float* WVB = SCL + 448;
        if (tid < 64) WVB[tid] = wv[(vcol >> 2) * 16 + tid];
        __syncthreads();
        f32x4 accC[4][2];
#pragma unroll
        for (int i = 0; i < 4; ++i) { accC[i][0] = (f32x4){0.f, 0.f, 0.f, 0.f}; accC[i][1] = (f32x4){0.f, 0.f, 0.f, 0.f}; }
        float m_st = -INFINITY;
        u32x4 raw[8]; u32x4 sraw; u32x2 xraw = (u32x2){0u, 0u}; float sa = 0.f, sli = 0.f, sml = 0.f, sgm, sal;
        const int vs = tid >> 2;
#define MLSTM_PREFETCH(CH) do { const int it_ = bh * 128 + (CH); const int r0_ = b * SEQ + (CH) * 64; \
            _Pragma("unroll") for (int i = 0; i < 8; ++i) raw[i] = *(const u32x4*)(CA + (size_t)(r0_ + w + 8 * i) * 2048 + h * 512 + lane * 8); \
            sraw = *(const u32x4*)(Sg + (size_t)it_ * 4096 + tid * 8); \
            const float* sp_ = scal + (size_t)it_ * 256; \
            if (tid < 256) { xraw = *(const u32x2*)(big + (size_t)(r0_ + vs) * 4096 + vcol + 4 * (tid & 3)); sa = sp_[vs]; sli = sp_[64 + vs]; } \
            else if (tid < 320) { sa = sp_[tid - 256]; sml = sp_[128 + tid - 256]; } \
            sgm = sp_[192]; sal = sp_[193]; } while (0)
        unsigned hpend[4] = {0u, 0u, 0u, 0u};
        MLSTM_PREFETCH(0);
        for (int ch = 0; ch < 128; ++ch) {
            const int r0 = b * SEQ + ch * 64;
            LAS float* SC = SCL + (ch & 1) * 192;
            const float m_new = fmaxf(sal + m_st, sgm);
            const float dec = __expf(sal + m_st - m_new);
#pragma unroll
            for (int i = 0; i < 8; ++i) *(LAS u32x4*)(c.lds + QT_O + (w + 8 * i) * 1040 + lane * 16) = raw[i];
            *(LAS u32x4*)(c.lds + SS_O + (tid >> 3) * PS + (tid & 7) * 16) = sraw;
            if (tid < 256) {
                const float x[4] = {lo_f(xraw.x), hi_f(xraw.x), lo_f(xraw.y), hi_f(xraw.y)};
                float v[4];
                const int nb = tid & 3;
#pragma unroll
                for (int e = 0; e < 4; ++e) v[e] = x[0] * WVB[nb * 16 + e] + x[1] * WVB[nb * 16 + 4 + e] + x[2] * WVB[nb * 16 + 8 + e] + x[3] * WVB[nb * 16 + 12 + e];
                const float ws_ = __expf(sal - sa + sli - m_new);
                *(LAS u32x2*)(c.lds + VA_O + vs * PV + nb * 8) = (u32x2){pack2(v[0], v[1]), pack2(v[2], v[3])};
                *(LAS u32x2*)(c.lds + VA_O + vs * PV + 32 + nb * 8) = (u32x2){nb == 0 ? 0x3F80u : 0u, 0u};
#pragma unroll
                for (int e = 0; e < 4; ++e) {
                    *(LAS bf16_t*)(c.lds + VHT_O + (4 * nb + e) * PT + vs * 2) = (bf16_t)f2bf(v[e] * ws_);
                    *(LAS bf16_t*)(c.lds + VHT_O + (16 + 4 * nb + e) * PT + vs * 2) = (bf16_t)((nb == 0 && e == 0) ? f2bf(ws_) : 0u);
                }
            } else if (tid < 320) {
                const int t = tid - 256;
                const float mt = fmaxf(sml, sa + m_st);
                SC[t] = __expf(sml - mt); SC[64 + t] = __expf(sa + m_st - mt); SC[128 + t] = __expf(-mt);
            }
            LDS_BAR();
            if (ch + 1 < 128) MLSTM_PREFETCH(ch + 1);
            if (ch > 0 && (w & 1) == 0) {
#pragma unroll
                for (int e = 0; e < 4; ++e) big[(size_t)(r0 - 64 + 16 * (w >> 1) + 4 * g4 + e) * 4096 + vcol + l15] = (bf16_t)hpend[e];
            }
            u32x4 xa[4][2];
#pragma unroll
            for (int tt = 0; tt < 4; ++tt)
#pragma unroll
                for (int kk = 0; kk < 2; ++kk) {
                    const unsigned qo = QT_O + (16 * tt + l15) * 1040 + (64 * w + 32 * kk + 4 * g4) * 2;
                    const u32x2 lo_ = *(const LAS u32x2*)(c.lds + qo), hi_ = *(const LAS u32x2*)(c.lds + qo + 32);
                    xa[tt][kk] = (u32x4){lo_.x, lo_.y, hi_.x, hi_.y};
                }
            {
                f32x4 pacc[4][2];
#pragma unroll
                for (int tt = 0; tt < 4; ++tt) { pacc[tt][0] = (f32x4){0.f, 0.f, 0.f, 0.f}; pacc[tt][1] = (f32x4){0.f, 0.f, 0.f, 0.f}; }
#pragma unroll
                for (int kk = 0; kk < 2; ++kk) {
                    bf16x8 y[2];
#pragma unroll
                    for (int nt = 0; nt < 2; ++nt) {
                        u32x4 pk = (u32x4){pack2(accC[2 * kk][nt][0], accC[2 * kk][nt][1]), pack2(accC[2 * kk][nt][2], accC[2 * kk][nt][3]),
                                           pack2(accC[2 * kk + 1][nt][0], accC[2 * kk + 1][nt][1]), pack2(accC[2 * kk + 1][nt][2], accC[2 * kk + 1][nt][3])};
                        y[nt] = *(bf16x8*)&pk;
                    }
#pragma unroll
                    for (int tt = 0; tt < 4; ++tt) { const bf16x8 x = *(bf16x8*)&xa[tt][kk];
                        pacc[tt][0] = mfma16(x, y[0], pacc[tt][0]); pacc[tt][1] = mfma16(x, y[1], pacc[tt][1]); }
                }
#pragma unroll
                for (int tt = 0; tt < 4; ++tt)
#pragma unroll
                    for (int nt = 0; nt < 2; ++nt) *(LAS f32x4*)(PART + (w * 32 + 16 * nt + l15) * 68 + 16 * tt + 4 * g4) = pacc[tt][nt];
            }
            const int itt = w >> 1, intt = w & 1;
            f32x4 a2 = (f32x4){0.f, 0.f, 0.f, 0.f}, a3 = (f32x4){0.f, 0.f, 0.f, 0.f};
            if (intt == 0) {
                for (int s0 = 0; s0 <= 16 * itt + 15; s0 += 32) {
                    const bf16x8 xs = row_load(c.lds, SS_O, PS, 16 * itt, s0, lane);
                    a2 = mfma16(xs, tr_load(c.ldsb + VA_O, PV, s0, 0, lane), a2);
                    a3 = mfma16(xs, tr_load(c.ldsb + VA_O, PV, s0, 16, lane), a3);
                }
            }
            {
                bf16x8 yv[2][2];
#pragma unroll
                for (int k2 = 0; k2 < 2; ++k2)
#pragma unroll
                    for (int nt = 0; nt < 2; ++nt) {
                        const unsigned vo = VHT_O + (16 * nt + l15) * PT + (32 * k2 + 4 * g4) * 2;
                        const u32x2 lo_ = *(const LAS u32x2*)(c.lds + vo), hi_ = *(const LAS u32x2*)(c.lds + vo + 32);
                        u32x4 pk = (u32x4){lo_.x, lo_.y, hi_.x, hi_.y}; yv[k2][nt] = *(bf16x8*)&pk;
                    }
#pragma unroll
                for (int i4 = 0; i4 < 4; ++i4) {
                    accC[i4][0] = accC[i4][0] * dec; accC[i4][1] = accC[i4][1] * dec;
#pragma unroll
                    for (int k2 = 0; k2 < 2; ++k2) {
                        const f32x4 z = (f32x4){0.f, 0.f, 0.f, 0.f};
                        const f32x4 k0 = mfma16(*(bf16x8*)&xa[2 * k2][i4 >> 1], mfr[i4], z), k1 = mfma16(*(bf16x8*)&xa[2 * k2 + 1][i4 >> 1], mfr[i4], z);
                        u32x4 pk = (u32x4){pack2(k0[0], k0[1]), pack2(k0[2], k0[3]), pack2(k1[0], k1[1]), pack2(k1[2], k1[3])};
                        const bf16x8 kf = *(bf16x8*)&pk;
                        accC[i4][0] = mfma16(kf, yv[k2][0], accC[i4][0]); accC[i4][1] = mfma16(kf, yv[k2][1], accC[i4][1]);
                    }
                }
            }
            LDS_BAR();
            if (intt == 0) {
                f32x4 isum = (f32x4){0.f, 0.f, 0.f, 0.f}, dsum = (f32x4){0.f, 0.f, 0.f, 0.f};
#pragma unroll
                for (int ww = 0; ww < 8; ++ww) {
                    isum = isum + *(const LAS f32x4*)(PART + (ww * 32 + l15) * 68 + 16 * itt + 4 * g4);
                    dsum = dsum + *(const LAS f32x4*)(PART + (ww * 32 + 16) * 68 + 16 * itt + 4 * g4);
                }
#pragma unroll
                for (int e = 0; e < 4; ++e) {
                    const int t = 16 * itt + 4 * g4 + e;
                    const float a3e = __shfl(a3[e], lane & 48, 64);
                    const float den = fmaxf(fabsf(SC[t] * a3e + SC[64 + t] * dsum[e]), SC[128 + t]);
                    const float num = SC[t] * a2[e] + SC[64 + t] * isum[e];
                    hpend[e] = f2bf(num * __builtin_amdgcn_rcpf(den));
                }
            }
            m_st = m_new;
        }
        if ((w & 1) == 0) {
#pragma unroll
            for (int e = 0; e < 4; ++e) big[(size_t)(b * SEQ + 127 * 64 + 16 * (w >> 1) + 4 * g4 + e) * 4096 + vcol + l15] = (bf16_t)hpend[e];
        }
        __syncthreads();
#undef MLSTM_PREFETCH
    }
}
DI void mlstm_norm_phase(const Ctx& c0, const bf16_t* big, bf16_t* CA, const float* __restrict__ norm_g, const float* __restrict__ skip) {
    const Ctx c = mk(c0);
    for (int p0 = (c.bid * 8 + c.wave) * 4; p0 < T * 4; p0 += c.nb * 8 * 4) {
        const int row = p0 >> 2;
        u32x4 hr[4], zr[4], cr[4]; float4 gq[4][2], kq[4][2];
#pragma unroll
        for (int h = 0; h < 4; ++h) { const int col = h * 512 + 8 * c.lane;
            hr[h] = *(const u32x4*)(big + (size_t)row * 4096 + col); zr[h] = *(const u32x4*)(big + (size_t)row * 4096 + 2048 + col); cr[h] = *(const u32x4*)(CA + (size_t)row * 2048 + col);
            gq[h][0] = *(const float4*)(norm_g + col); gq[h][1] = *(const float4*)(norm_g + col + 4); kq[h][0] = *(const float4*)(skip + col); kq[h][1] = *(const float4*)(skip + col + 4); }
#pragma unroll
        for (int h = 0; h < 4; ++h) {
            const int col = h * 512 + 8 * c.lane;
            float x[8] = {lo_f(hr[h].x), hi_f(hr[h].x), lo_f(hr[h].y), hi_f(hr[h].y), lo_f(hr[h].z), hi_f(hr[h].z), lo_f(hr[h].w), hi_f(hr[h].w)};
            const float z[8] = {lo_f(zr[h].x), hi_f(zr[h].x), lo_f(zr[h].y), hi_f(zr[h].y), lo_f(zr[h].z), hi_f(zr[h].z), lo_f(zr[h].w), hi_f(zr[h].w)};
            const float ca[8] = {lo_f(cr[h].x), hi_f(cr[h].x), lo_f(cr[h].y), hi_f(cr[h].y), lo_f(cr[h].z), hi_f(cr[h].z), lo_f(cr[h].w), hi_f(cr[h].w)};
            float sm = 0.f;
#pragma unroll
            for (int i = 0; i < 8; ++i) sm += x[i];
            const float mean = wave_sum(sm) * (1.0f / 512.f);
            float q = 0.f;
#pragma unroll
            for (int i = 0; i < 8; ++i) { x[i] -= mean; q += x[i] * x[i]; }
            const float rstd = rsqrtf(wave_sum(q) * (1.0f / 512.f) + 1e-6f);
            const float4 g0 = gq[h][0], g1 = gq[h][1], k0 = kq[h][0], k1 = kq[h][1];
            const float gg[8] = {g0.x, g0.y, g0.z, g0.w, g1.x, g1.y, g1.z, g1.w}, sk[8] = {k0.x, k0.y, k0.z, k0.w, k1.x, k1.y, k1.z, k1.w};
            float o[8];
#pragma unroll
            for (int i = 0; i < 8; ++i) o[i] = (x[i] * rstd * gg[i] + sk[i] * ca[i]) * siluf_(z[i]);
            *(u32x4*)(CA + (size_t)row * 2048 + col) = (u32x4){pack2(o[0], o[1]), pack2(o[2], o[3]), pack2(o[4], o[5]), pack2(o[6], o[7])};
        }
    }
}

#ifndef PHSEL
#define PHSEL -1
#endif
#ifndef GSEL
#define GSEL -1
#endif
__global__ void __launch_bounds__(NTHR, 2) trunk_fwd(Args args) {
    extern __shared__ __attribute__((aligned(16))) unsigned char shm[];
    cg::grid_group grid = cg::this_grid();
    Ctx c;
    c.lds = (LAS unsigned char*)shm; c.ldsb = (unsigned)(uintptr_t)c.lds;
    c.tid = threadIdx.x; c.lane = c.tid & 63; c.wave = __builtin_amdgcn_readfirstlane(c.tid >> 6); c.bid = blockIdx.x; c.nb = gridDim.x;
    unsigned char* ws = args.ws;
    if (c.tid < 4) ((LAS unsigned*)(c.lds + LDS_BARST))[c.tid] = 0u;
    __syncthreads();
    const XcdBarrier xbar = xcd_barrier_post((unsigned*)(ws + WS_BAR), (volatile LAS unsigned*)(c.lds + LDS_BARST));
    bf16_t* Win = (bf16_t*)(ws + WS_WIN); bf16_t* Wout = (bf16_t*)(ws + WS_WOUT); bf16_t* W1 = (bf16_t*)(ws + WS_W1); bf16_t* W2 = (bf16_t*)(ws + WS_W2);
    bf16_t* HN = (bf16_t*)(ws + WS_HN); bf16_t* BIG = (bf16_t*)(ws + WS_BIG); bf16_t* CA = (bf16_t*)(ws + WS_CA);
    float* gates = (float*)(ws + WS_GATES); float* scal = (float*)(ws + WS_SCAL); float* dec = (float*)(ws + WS_DEC); float* stats = (float*)(ws + WS_STATS);
    bf16_t* SMAT = Win;
    float* H = args.out;
    const float* const* in = args.in;

    float* ssqA = (float*)(ws + WS_SSQA); float* ssqB = (float*)(ws + WS_SSQB);
#ifdef PROBE_L
    for (int pass = 0; pass < 2; ++pass)
#endif
    for (int layer = 0; layer < 4; ++layer) {
        const int kind = layer % 3, j = layer / 3;
        const int nmid = (kind == 0) ? 1 : (kind == 1 ? 3 : 4);
        const int nsteps = nmid + 5;
        for (int st = (layer == 0 ? 0 : 1); st < nsteps; ++st) {
#ifdef PROBE_L
            if (pass == 0 && (layer > PROBE_L || (layer == PROBE_L && st >= PROBE_S))) break;
#endif
            const int gsel = (st == 1) ? 0 : (st == nmid + 2) ? 1 : (st == nmid + 3) ? 2 : (st == nmid + 4) ? 3 : -1;
            if (gsel >= 0) {
                const bf16_t* A; const bf16_t* Bt; int lda, N, K, mode; const float* sin_ = ssqA; float* sout = ssqA;
                if (gsel == 0) { A = HN; lda = 1024; Bt = Win; N = 4096; K = 1024; mode = (kind == 0) ? 1 : 0; sin_ = ssqA; }
                else if (gsel == 1) { Bt = Wout; N = 1024; mode = 3; sout = ssqB;
                    if (kind == 0) { A = BIG; lda = 4096; K = 2048; } else if (kind == 1) { A = BIG + 3072; lda = 4096; K = 1024; } else { A = CA; lda = 2048; K = 2048; } }
                else if (gsel == 2) { A = HN; lda = 1024; Bt = W1; N = 4096; K = 1024; mode = 2; sin_ = ssqB; }
                else { A = BIG; lda = 4096; Bt = W2; N = 1024; K = 4096; mode = 3; sout = ssqA; }
                if (PHSEL < 0 || PHSEL == 2) run_gemm(c, A, lda, Bt, N, K, mode, BIG, HN, sin_, sout, (float*)CA);
                if (PHSEL < 0 || PHSEL == 0) {
                    if (gsel == 3 && layer < 3) {
                        const int nl = layer + 1, nk = nl % 3, nj = nl / 3;
                        const float* win = (nk == 0) ? in[7] + (size_t)nj * 1024 * 4096 : (nk == 1 ? in[13] : in[16]);
                        const float* wout = (nk == 0) ? in[12] + (size_t)nj * 2048 * 1024 : (nk == 1 ? in[15] : in[26]);
                        convert_wT(c, win, Win, 1024, 4096, in[1] + nl * 1024);
                        convert_wT(c, wout, Wout, nk == 1 ? 1024 : 2048, 1024, nullptr);
                        convert_wT(c, in[4] + (size_t)nl * 1024 * 4096, W1, 1024, 4096, in[2] + nl * 1024);
                    }
                    if (gsel == 0 && layer > 0) convert_wT(c, in[5] + (size_t)layer * 4096 * 1024, W2, 4096, 1024, nullptr);
                }
            } else if (st == 0) {
                const float* win = (kind == 0) ? in[7] + (size_t)j * 1024 * 4096 : (kind == 1 ? in[13] : in[16]);
                const float* wout = (kind == 0) ? in[12] + (size_t)j * 2048 * 1024 : (kind == 1 ? in[15] : in[26]);
                if (PHSEL < 0 || PHSEL == 0) {
                    convert_wT(c, win, Win, 1024, 4096, in[1] + layer * 1024);
                    convert_wT(c, wout, Wout, kind == 1 ? 1024 : 2048, 1024, nullptr);
                    convert_wT(c, in[4] + (size_t)layer * 1024 * 4096, W1, 1024, 4096, in[2] + layer * 1024);
                    convert_wT(c, in[5] + (size_t)layer * 4096 * 1024, W2, 4096, 1024, nullptr);
                }
                if (layer == 0) { if (PHSEL < 0 || PHSEL == 1) prologue_phase(c, in[0], HN, ssqA); }
            } else {
                const int m = st - 2;
                if (kind == 0) {
                    { if (PHSEL < 0 || PHSEL == 4) gmlp_spatial_phase(c, BIG, (const float*)CA, in[10] + (size_t)j * 16 * 128 * 128, in[11] + (size_t)j * 16 * 128, in[8] + (size_t)j * 2048, in[9] + (size_t)j * 2048); }
                } else if (kind == 1) {
                    if (m == 0) { if (PHSEL < 0 || PHSEL == 5) hgrn_local_phase(c, BIG, CA, dec, in[6], layer); }
                    else if (m == 1) { if (PHSEL < 0 || PHSEL == 6) hgrn_scan_phase(c, CA, dec); }
                    else { if (PHSEL < 0 || PHSEL == 7) hgrn_out_phase(c, BIG, CA, in[14]); }
                } else {
                    if (m == 0) { if (PHSEL < 0 || PHSEL == 8) mlstm_conv_phase(c, BIG, CA, gates, in[17], in[18], in[19], in[20], in[21], in[22], in[23]); }
                    else if (m == 1) { if (PHSEL < 0 || PHSEL == 9) mlstm_smat_phase(c, CA, gates, scal, SMAT, in[19], in[20]); }
                    else if (m == 2) { if (PHSEL < 0 || PHSEL == 10) mlstm_scan_phase(c, BIG, CA, scal, SMAT, in[19], in[20], in[21]); }
                    else { if (PHSEL < 0 || PHSEL == 11) mlstm_norm_phase(c, BIG, CA, in[25], in[24]); }
                }
            }
            if (args.use_cg) grid.sync();
            else xcd_barrier(xbar);
            if (layer == 0 && st == 0) {
                if (c.tid < 64) {
                    unsigned* bw = (unsigned*)(ws + WS_BAR);
                    const unsigned cnt = (c.tid < 16) ? xb_ld(&bw[XB_XCNT(c.tid)]) : 0u;
                    const bool good = (c.tid >= 16) || (cnt == (c.tid < 8 ? (unsigned)c.nb / 8u : 0u));
                    const bool ok = ((c.nb % 8) == 0) && (__ballot(good) == ~0ull);
                    volatile LAS unsigned* stw = (volatile LAS unsigned*)(c.lds + LDS_BARST);
                    if (c.tid == 0) stw[3] = ok ? stw[2] * 8u + xbar.x : (unsigned)blockIdx.x;
                }
                __syncthreads();
                c.bid = __builtin_amdgcn_readfirstlane((int)((volatile LAS unsigned*)(c.lds + LDS_BARST))[3]);
            }
        }
    }
    if (PHSEL < 0 || PHSEL == 12) final_norm_phase(c, HN, H, in[3], ssqA);
}

extern "C" void kernel_launch(void* const* d_in, const int* in_sizes, int n_in, void* d_out, int out_size, void* d_ws, size_t ws_size, hipStream_t stream) {
    static int grid = 0;
    if (grid == 0) {
        if (n_in != 27 || out_size != T * DM || ws_size < WS_END) { fprintf(stderr, "kernel_launch: unexpected shapes (n_in %d out %d ws %zu)\n", n_in, out_size, ws_size); grid = -1; return; }
        int dev = 0, cus = 0, per_cu = 0;
        hipGetDevice(&dev);
        hipDeviceGetAttribute(&cus, hipDeviceAttributeMultiprocessorCount, dev);
        if (hipFuncSetAttribute((const void*)trunk_fwd, hipFuncAttributeMaxDynamicSharedMemorySize, LDS_BYTES) != hipSuccess) { fprintf(stderr, "kernel_launch: hipFuncSetAttribute failed\n"); grid = -1; return; }
        if (hipOccupancyMaxActiveBlocksPerMultiprocessor(&per_cu, (const void*)trunk_fwd, NTHR, LDS_BYTES) != hipSuccess || per_cu < 1) { fprintf(stderr, "kernel_launch: occupancy query failed (%d)\n", per_cu); (void)hipGetLastError(); per_cu = 1; }
        grid = cus * 1;
        fprintf(stderr, "kernel_launch: grid %d (cus %d, per_cu %d)\n", grid, cus, per_cu);
    }
    if (grid < 0) return;
    if (hipMemsetAsync((char*)d_ws + WS_BAR, 0, XCD_BAR_WORDS * sizeof(unsigned), stream) != hipSuccess) { fprintf(stderr, "kernel_launch: memset of the barrier words failed\n"); return; }
    Args a{};
    for (int i = 0; i < 27; ++i) a.in[i] = (const float*)d_in[i];
    a.out = (float*)d_out; a.ws = (unsigned char*)d_ws; a.use_cg = 0; a.pad = 0;
    void* params[] = {&a};
    hipError_t e = hipLaunchCooperativeKernel((const void*)trunk_fwd, dim3(grid), dim3(NTHR), params, LDS_BYTES, stream);
    if (e != hipSuccess) fprintf(stderr, "kernel_launch: cooperative launch failed: %s\n", hipGetErrorString(e));
}
```

```cpp
#include <hip/hip_runtime.h>
#include <hip/hip_cooperative_groups.h>
#include <cstdio>
#include <cstdint>
namespace cg = cooperative_groups;

#define DI __device__ __forceinline__
#define LAS __attribute__((address_space(3)))
typedef unsigned short bf16_t;
typedef short bf16x8 __attribute__((ext_vector_type(8)));
typedef short s16x4 __attribute__((ext_vector_type(4)));
typedef float f32x4 __attribute__((ext_vector_type(4)));
typedef float f32x2 __attribute__((ext_vector_type(2)));
typedef unsigned u32x4 __attribute__((ext_vector_type(4)));
typedef unsigned u32x2 __attribute__((ext_vector_type(2)));

constexpr int T = 16384, DM = 1024, SEQ = 8192;
constexpr int NTHR = 512;
constexpr int LDS_BYTES = 157696;
constexpr int LDS_BARST = 157680;

constexpr size_t MB = 1024 * 1024;
constexpr size_t WS_WIN = 0;
constexpr size_t WS_WOUT = 8 * MB;
constexpr size_t WS_W1 = 12 * MB;
constexpr size_t WS_W2 = 20 * MB;
constexpr size_t WS_MISC = 28 * MB;
constexpr size_t WS_GATES = WS_MISC;
constexpr size_t WS_SCAL = WS_MISC + 512 * 1024;
constexpr size_t WS_DEC = WS_MISC;
constexpr size_t WS_STATS = WS_MISC;
constexpr size_t WS_SSQA = WS_MISC + 1536 * 1024;
constexpr size_t WS_SSQB = WS_MISC + 2560 * 1024;
constexpr size_t WS_BAR = WS_MISC + 3584 * 1024;
constexpr size_t WS_HN = 32 * MB;
constexpr size_t WS_BIG = 64 * MB;
constexpr size_t WS_CA = 192 * MB;
constexpr size_t WS_END = 256 * MB;

DI float bf2f(unsigned b) { return __uint_as_float(b << 16); }
typedef __bf16 nbf16x2 __attribute__((ext_vector_type(2)));
DI unsigned pack2(float lo, float hi) { nbf16x2 v; v.x = (__bf16)lo; v.y = (__bf16)hi; return __builtin_bit_cast(unsigned, v); }
DI unsigned f2bf(float f) { return pack2(f, 0.f) & 0xFFFFu; }
DI float lo_f(unsigned w) { return __uint_as_float(w << 16); }
DI float hi_f(unsigned w) { return __uint_as_float(w & 0xFFFF0000u); }
DI float sigmoidf_(float x) { return __builtin_amdgcn_rcpf(1.0f + __expf(-x)); }
DI float siluf_(float x) { return x * __builtin_amdgcn_rcpf(1.0f + __expf(-x)); }
DI float wave_sum(float v) {
#pragma unroll
    for (int o = 32; o >= 1; o >>= 1) v += __shfl_xor(v, o, 64);
    return v;
}
DI float wave_max(float v) {
#pragma unroll
    for (int o = 32; o >= 1; o >>= 1) v = fmaxf(v, __shfl_xor(v, o, 64));
    return v;
}
DI bf16x8 tr_frag(unsigned a0, unsigned a1) {
    s16x4 r0, r1;
    asm volatile("ds_read_b64_tr_b16 %0, %2\n\tds_read_b64_tr_b16 %1, %3\n\ts_waitcnt lgkmcnt(0)" : "=&v"(r0), "=&v"(r1) : "v"(a0), "v"(a1) : "memory");
    bf16x8 r; r[0] = r0[0]; r[1] = r0[1]; r[2] = r0[2]; r[3] = r0[3]; r[4] = r1[0]; r[5] = r1[1]; r[6] = r1[2]; r[7] = r1[3];
    return r;
}
DI unsigned tr_addr(unsigned base, int pitch, int k0, int n0, int lane) {
    const int g = lane >> 4, q = (lane & 15) >> 2, p = lane & 3;
    return base + (unsigned)((k0 + 8 * g + q) * pitch + (n0 + 4 * p) * 2);
}
DI bf16x8 tr_load(unsigned base, int pitch, int k0, int n0, int lane) { const unsigned a = tr_addr(base, pitch, k0, n0, lane); return tr_frag(a, a + 4 * pitch); }
DI void tr_load4(bf16x8 (&o)[4], unsigned a0, unsigned a1, unsigned a2, unsigned a3, int pitch) {
    s16x4 r0, r1, r2, r3, r4, r5, r6, r7;
    const unsigned b0 = a0 + 4 * pitch, b1 = a1 + 4 * pitch, b2 = a2 + 4 * pitch, b3 = a3 + 4 * pitch;
    asm volatile("ds_read_b64_tr_b16 %0, %8\n\tds_read_b64_tr_b16 %1, %9\n\tds_read_b64_tr_b16 %2, %10\n\tds_read_b64_tr_b16 %3, %11\n\t"
                 "ds_read_b64_tr_b16 %4, %12\n\tds_read_b64_tr_b16 %5, %13\n\tds_read_b64_tr_b16 %6, %14\n\tds_read_b64_tr_b16 %7, %15\n\ts_waitcnt lgkmcnt(0)"
                 : "=&v"(r0), "=&v"(r1), "=&v"(r2), "=&v"(r3), "=&v"(r4), "=&v"(r5), "=&v"(r6), "=&v"(r7)
                 : "v"(a0), "v"(b0), "v"(a1), "v"(b1), "v"(a2), "v"(b2), "v"(a3), "v"(b3) : "memory");
    o[0] = (bf16x8){r0[0], r0[1], r0[2], r0[3], r1[0], r1[1], r1[2], r1[3]};
    o[1] = (bf16x8){r2[0], r2[1], r2[2], r2[3], r3[0], r3[1], r3[2], r3[3]};
    o[2] = (bf16x8){r4[0], r4[1], r4[2], r4[3], r5[0], r5[1], r5[2], r5[3]};
    o[3] = (bf16x8){r6[0], r6[1], r6[2], r6[3], r7[0], r7[1], r7[2], r7[3]};
}
DI bf16x8 row_load(LAS unsigned char* lds, unsigned base, int pitch, int r0, int k0, int lane) {
    return *(const LAS bf16x8*)(lds + base + (unsigned)((r0 + (lane & 15)) * pitch + (k0 + 8 * (lane >> 4)) * 2));
}
#define LDS_BAR() do { asm volatile("s_waitcnt lgkmcnt(0)" ::: "memory"); __builtin_amdgcn_s_barrier(); asm volatile("" ::: "memory"); } while (0)
DI f32x4 mfma16(bf16x8 a, bf16x8 b, f32x4 c) { return __builtin_amdgcn_mfma_f32_16x16x32_bf16(a, b, c, 0, 0, 0); }

namespace pg8 {
constexpr int BM = 256, BK = 64, HALF = 128, HTB = HALF * BK * 2, STAGE_BYTES = 8 * HTB, NXCD = 8, WGM = 8;
DI int lds_byte(int r, int c) { const int st = (r >> 4) * 2 + (c >> 5), rr = r & 15, cc = c & 31, ob = rr * 64 + cc * 2; return st * 1024 + (ob ^ (((ob >> 9) & 1) << 5)); }
DI void stage_rc(int b, int& R, int& C) { const int st = b / 1024, sb = b % 1024, swz = sb ^ (((sb >> 9) & 1) << 5); R = (st >> 1) * 16 + swz / 64; C = (st & 1) * 32 + (swz % 64) / 2; }
DI int perm32(int rho) { const int n = rho >> 4, i = rho & 15; return 8 * (i >> 2) + 4 * n + (i & 3); }
struct Unit { int pm, pn; };
struct Gemm { const bf16_t* A; const bf16_t* Bt; int M, N, K, lda; };
struct StaticOrder {
    int nM, nN, nwg, G, c;
    DI void init(int M, int N, int G_, int c_) { nM = M / BM; nN = N / BM; nwg = nM * nN; G = G_; c = c_; }
    DI bool next(int i, Unit& u) const {
        const long L = (long)i * G + c; if (L >= nwg) return false;
        int wgid = (int)L; { const int q = nwg / NXCD, r = nwg % NXCD, xcd = wgid % NXCD, off = wgid / NXCD; wgid = (xcd < r ? xcd * (q + 1) : r * (q + 1) + (xcd - r) * q) + off; }
        const int nig = WGM * nN, gid = wgid / nig, fm = gid * WGM, gsz = (nM - fm) < WGM ? (nM - fm) : WGM;
        u.pm = fm + ((wgid % nig) % gsz); u.pn = (wgid % nig) / gsz; return true;
    }
};
DI unsigned cvt_pk_bf16(float lo, float hi) { unsigned r; asm volatile("v_cvt_pk_bf16_f32 %0, %1, %2" : "=v"(r) : "v"(lo), "v"(hi)); return r; }
DI f32x2 gelu_pk(f32x2 v) {
    const f32x2 av = __builtin_elementwise_abs(v), d = av * 0.2316418882f + 1.0f;
    f32x2 t; t.x = __builtin_amdgcn_rcpf(d.x); t.y = __builtin_amdgcn_rcpf(d.y);
    f32x2 q = t * 0.5307027145f + (-0.7265760135f); q = q * t + 0.7107068705f; q = q * t + (-0.142248368f); q = q * t + 0.127414796f; q = q * t;
    const f32x2 s = (v * v) * (-0.72134752044f);
    f32x2 e; e.x = __builtin_amdgcn_exp2f(s.x); e.y = __builtin_amdgcn_exp2f(s.y);
    const f32x2 m = v * (q * e), r = v - m;
    f32x2 o; o.x = v.x < 0.f ? m.x : r.x; o.y = v.y < 0.f ? m.y : r.y; return o;
}
struct EpiAny {
    int mode; bf16_t* O; bf16_t* HB; const LAS float* rstd_tab; float* ssq_out; float* vstat;
    DI bool perm() const { return true; }
    DI void operator()(const f32x4 (&acc)[2][2][4][2], const Unit& u, int wr, int wc, int fr, int fq, int ui) const {
        if (mode == 3) {
            const int row0 = u.pm * BM + wr * 64 + fr, col0 = u.pn * BM + wc * 32 + 8 * fq;
#pragma unroll
            for (int ai = 0; ai < 2; ++ai) {
                u32x4 oldv[4][2];
#pragma unroll
                for (int m = 0; m < 4; ++m)
#pragma unroll
                    for (int bj = 0; bj < 2; ++bj) oldv[m][bj] = *(const u32x4*)(HB + (size_t)(row0 + ai * HALF + m * 16) * 1024 + col0 + bj * HALF);
#pragma unroll
                for (int m = 0; m < 4; ++m) { const int row = row0 + ai * HALF + m * 16; bf16_t* hb = HB + (size_t)row * 1024 + col0;
                    float ss = 0.f;
#pragma unroll
                    for (int bj = 0; bj < 2; ++bj) { const u32x4 old = oldv[m][bj];
                        const f32x4 a0 = acc[ai][bj][m][0], a1 = acc[ai][bj][m][1];
                        u32x4 w; w.x = cvt_pk_bf16(lo_f(old.x) + a0[0], hi_f(old.x) + a0[1]); w.y = cvt_pk_bf16(lo_f(old.y) + a0[2], hi_f(old.y) + a0[3]);
                        w.z = cvt_pk_bf16(lo_f(old.z) + a1[0], hi_f(old.z) + a1[1]); w.w = cvt_pk_bf16(lo_f(old.w) + a1[2], hi_f(old.w) + a1[3]);
                        *(u32x4*)(hb + bj * HALF) = w;
                        const float r0 = lo_f(w.x), r1 = hi_f(w.x), r2 = lo_f(w.y), r3 = hi_f(w.y), r4 = lo_f(w.z), r5 = hi_f(w.z), r6 = lo_f(w.w), r7 = hi_f(w.w);
                        ss += (r0 * r0 + r1 * r1) + (r2 * r2 + r3 * r3) + (r4 * r4 + r5 * r5) + (r6 * r6 + r7 * r7); }
                    ss += __shfl_xor(ss, 16, 64); ss += __shfl_xor(ss, 32, 64);
                    if (fq == 0) ssq_out[row * 16 + u.pn * 4 + wc] = ss; }
            }
        } else {
            const int row0 = u.pm * BM + wr * 64 + fr, col0 = u.pn * BM + wc * 32 + 8 * fq;
#pragma unroll
            for (int ai = 0; ai < 2; ++ai)
#pragma unroll
                for (int m = 0; m < 4; ++m) { const int row = row0 + ai * HALF + m * 16; bf16_t* rowp = O + (size_t)row * 4096 + col0;
                    const float rs = rstd_tab[(ui & 3) * 256 + wr * 64 + fr + ai * HALF + m * 16];
                    float st1 = 0.f, st2 = 0.f;
#pragma unroll
                    for (int bj = 0; bj < 2; ++bj) { f32x4 v0 = acc[ai][bj][m][0] * rs, v1 = acc[ai][bj][m][1] * rs;
                        if (mode == 1) { f32x2 a = gelu_pk((f32x2){v0[0], v0[1]}), b = gelu_pk((f32x2){v0[2], v0[3]}), c = gelu_pk((f32x2){v1[0], v1[1]}), d = gelu_pk((f32x2){v1[2], v1[3]});
                            v0 = (f32x4){a.x, a.y, b.x, b.y}; v1 = (f32x4){c.x, c.y, d.x, d.y}; }
                        else if (mode == 2) {
#pragma unroll
                            for (int j = 0; j < 4; ++j) { const float a = fmaxf(v0[j], 0.f), b = fmaxf(v1[j], 0.f); v0[j] = a * a; v1[j] = b * b; } }
                        u32x4 w; w.x = cvt_pk_bf16(v0[0], v0[1]); w.y = cvt_pk_bf16(v0[2], v0[3]); w.z = cvt_pk_bf16(v1[0], v1[1]); w.w = cvt_pk_bf16(v1[2], v1[3]);
                        *(u32x4*)(rowp + bj * HALF) = w;
                        if (mode == 1 && u.pn >= 8) {
                            const float r0 = lo_f(w.x), r1 = hi_f(w.x), r2 = lo_f(w.y), r3 = hi_f(w.y), r4 = lo_f(w.z), r5 = hi_f(w.z), r6 = lo_f(w.w), r7 = hi_f(w.w);
                            st1 += (r0 + r1) + (r2 + r3) + (r4 + r5) + (r6 + r7);
                            st2 += (r0 * r0 + r1 * r1) + (r2 * r2 + r3 * r3) + (r4 * r4 + r5 * r5) + (r6 * r6 + r7 * r7); } }
                    if (mode == 1 && u.pn >= 8) {
                        st1 += __shfl_xor(st1, 16, 64); st1 += __shfl_xor(st1, 32, 64); st2 += __shfl_xor(st2, 16, 64); st2 += __shfl_xor(st2, 32, 64);
                        if (fq == 0) *(f32x2*)(vstat + ((size_t)row * 32 + (u.pn - 8) * 4 + wc) * 2) = (f32x2){st1, st2}; } }
        }
    }
};

template <class Epi, class Sched>
DI void gemm_phase(LAS unsigned char* lds, const Gemm g, const Sched& S, const Epi& E, const int tid) {
    const int wid = __builtin_amdgcn_readfirstlane(tid >> 6), lane = tid & 63, wr = wid >> 2, wc = wid & 3, fr = lane & 15, fq = lane >> 4;
    const int K = g.K, nt = K / BK;
    unsigned voffA[2], voffB[2];
#pragma unroll
    for (int i = 0; i < 2; ++i) { int R, C; stage_rc(tid * 16 + i * 8192, R, C); const int Rb = E.perm() ? ((R & ~31) + perm32(R & 31)) : R;
        voffA[i] = (unsigned)(R * g.lda + C) * 2u; voffB[i] = (unsigned)(Rb * K + C) * 2u; }
    const size_t kstep = (size_t)(BK * 2);
    const size_t hstepA = (size_t)HALF * g.lda * 2, hstepB = (size_t)HALF * K * 2;
    const size_t tstepA = 2 * hstepA, tstepB = 2 * hstepB;
    const unsigned ldsw = (unsigned)wid * 1024u;
    const int aoff = lds_byte(wr * 64 + fr, fq * 8), boff = lds_byte(wc * 32 + fr, fq * 8);
#define PG8_SA(b, h) (((b) * 2 + (h)) * HTB)
#define PG8_SB(b, h) ((4 + (b) * 2 + (h)) * HTB)
#define PG8_STAGE(bufoff, gbase, voff) do { _Pragma("unroll") for (int _i = 0; _i < 2; ++_i) \
        __builtin_amdgcn_global_load_lds((const unsigned*)((const char*)(gbase) + (voff)[_i]), (LAS unsigned*)(lds + (bufoff) + ldsw + _i * 8192), 16, 0, 0); } while (0)
#define PG8_LDA(dst, b, h) do { _Pragma("unroll") for (int m = 0; m < 4; ++m) _Pragma("unroll") for (int k = 0; k < 2; ++k) dst[m][k] = *(const LAS bf16x8*)(lds + PG8_SA(b, h) + aoff + m * 2048 + k * 1024); } while (0)
#define PG8_LDB(dst, b, h) do { _Pragma("unroll") for (int n = 0; n < 2; ++n) _Pragma("unroll") for (int k = 0; k < 2; ++k) dst[n][k] = *(const LAS bf16x8*)(lds + PG8_SB(b, h) + boff + n * 2048 + k * 1024); } while (0)
#define PG8_MMA(ai, bj, At, Bt) do { __builtin_amdgcn_s_setprio(1); _Pragma("unroll") for (int m = 0; m < 4; ++m) _Pragma("unroll") for (int n = 0; n < 2; ++n) _Pragma("unroll") for (int k = 0; k < 2; ++k) \
        acc[ai][bj][m][n] = __builtin_amdgcn_mfma_f32_16x16x32_bf16(Bt[n][k], At[m][k], acc[ai][bj][m][n], 0, 0, 0); __builtin_amdgcn_s_setprio(0); } while (0)
#define PG8_WAIT_V(n) asm volatile("s_waitcnt vmcnt(" #n ")" ::: "memory")
#define PG8_WAIT_L(n) asm volatile("s_waitcnt lgkmcnt(" #n ")" ::: "memory")
#define PG8_BAR __builtin_amdgcn_s_barrier()
#define PG8_SCHED __builtin_amdgcn_sched_barrier(0)
    Unit cur, nxt; int ui = 0;
    if (!S.next(0, cur)) return;
    f32x4 acc[2][2][4][2];
#pragma unroll
    for (int a = 0; a < 2; ++a)
#pragma unroll
        for (int b = 0; b < 2; ++b)
#pragma unroll
            for (int m = 0; m < 4; ++m)
#pragma unroll
                for (int n = 0; n < 2; ++n) acc[a][b][m][n] = (f32x4){0.f, 0.f, 0.f, 0.f};
    bf16x8 At[4][2], B0[2][2], B1[2][2];
    const char* cA = (const char*)g.A + (size_t)cur.pm * tstepA; const char* cB = (const char*)g.Bt + (size_t)cur.pn * tstepB;
    PG8_STAGE(PG8_SB(0, 0), cB, voffB); PG8_STAGE(PG8_SA(0, 0), cA, voffA); PG8_STAGE(PG8_SB(0, 1), cB + hstepB, voffB); PG8_STAGE(PG8_SA(0, 1), cA + hstepA, voffA);
    if (wr == 1) PG8_BAR;
    PG8_WAIT_V(4); PG8_BAR;
    PG8_STAGE(PG8_SB(1, 0), cB + kstep, voffB); PG8_STAGE(PG8_SA(1, 0), cA + kstep, voffA); PG8_STAGE(PG8_SB(1, 1), cB + hstepB + kstep, voffB);
    PG8_WAIT_V(6); PG8_BAR;
    for (;;) {
        const bool has_next = S.next(ui + 1, nxt);
        const char* nA = has_next ? (const char*)g.A + (size_t)nxt.pm * tstepA : cA; const char* nB = has_next ? (const char*)g.Bt + (size_t)nxt.pn * tstepB : cB;
        for (int t = 0; t < nt; t += 2) {
            const bool last = (t == nt - 2);
            const char* a1 = cA + (size_t)(t + 1) * kstep;
            const char* a2 = last ? nA : cA + (size_t)(t + 2) * kstep; const char* b2 = last ? nB : cB + (size_t)(t + 2) * kstep;
            const char* a3 = a2 + kstep; const char* b3 = b2 + kstep;
            PG8_LDB(B0, 0, 0); PG8_SCHED; PG8_LDA(At, 0, 0); PG8_STAGE(PG8_SA(1, 1), a1 + hstepA, voffA);
            PG8_WAIT_L(8); PG8_BAR; PG8_WAIT_L(0); PG8_MMA(0, 0, At, B0); PG8_BAR; PG8_SCHED;
            PG8_LDB(B1, 0, 1); PG8_STAGE(PG8_SB(0, 0), b2, voffB);
            PG8_BAR; PG8_WAIT_L(0); PG8_MMA(0, 1, At, B1); PG8_BAR;
            PG8_LDA(At, 0, 1); PG8_STAGE(PG8_SA(0, 0), a2, voffA);
            PG8_BAR; PG8_WAIT_L(0); PG8_MMA(1, 0, At, B0); PG8_BAR; PG8_SCHED;
            PG8_STAGE(PG8_SB(0, 1), b2 + hstepB, voffB);
            PG8_WAIT_V(6); PG8_BAR; PG8_MMA(1, 1, At, B1); PG8_BAR;
            PG8_LDB(B0, 1, 0); PG8_SCHED; PG8_LDA(At, 1, 0); PG8_STAGE(PG8_SA(0, 1), a2 + hstepA, voffA);
            PG8_WAIT_L(8); PG8_BAR; PG8_WAIT_L(0); PG8_MMA(0, 0, At, B0); PG8_BAR; PG8_SCHED;
            PG8_LDB(B1, 1, 1); PG8_STAGE(PG8_SB(1, 0), b3, voffB);
            PG8_BAR; PG8_WAIT_L(0); PG8_MMA(0, 1, At, B1); PG8_BAR;
            PG8_LDA(At, 1, 1); PG8_STAGE(PG8_SA(1, 0), a3, voffA);
            PG8_BAR; PG8_WAIT_L(0); PG8_MMA(1, 0, At, B0); PG8_BAR; PG8_SCHED;
            PG8_STAGE(PG8_SB(1, 1), b3 + hstepB, voffB);
            PG8_WAIT_V(6); PG8_BAR; PG8_MMA(1, 1, At, B1); PG8_BAR;
        }
        E(acc, cur, wr, wc, fr, fq, ui);
        if (!has_next) break;
#pragma unroll
        for (int a = 0; a < 2; ++a)
#pragma unroll
            for (int b = 0; b < 2; ++b)
#pragma unroll
                for (int m = 0; m < 4; ++m)
#pragma unroll
                    for (int n = 0; n < 2; ++n) acc[a][b][m][n] = (f32x4){0.f, 0.f, 0.f, 0.f};
        cur = nxt; cA = nA; cB = nB; ++ui;
    }
    PG8_WAIT_V(0);
    if (wr == 0) PG8_BAR;
    PG8_BAR;
#undef PG8_SA
#undef PG8_SB
#undef PG8_STAGE
#undef PG8_LDA
#undef PG8_LDB
#undef PG8_MMA
#undef PG8_WAIT_V
#undef PG8_WAIT_L
#undef PG8_BAR
#undef PG8_SCHED
}
}

#define XB_TMO      128
#define XB_XCNT(j)  (256  + 64 * (j))
#define XB_XSUB(j)  (1280 + 64 * (j))
#define XB_XGEN(j)  (2304 + 64 * (j))
#define XB_TOP      3328
#define XB_TOPGEN   3392
#define XCD_BAR_WORDS 3456
#define XB_SPIN_CAP (1u << 18)
DI unsigned xb_ld(unsigned* p)              { return __hip_atomic_load(p, __ATOMIC_RELAXED, __HIP_MEMORY_SCOPE_AGENT); }
DI unsigned xb_add(unsigned* p, unsigned v) { return __hip_atomic_fetch_add(p, v, __ATOMIC_RELAXED, __HIP_MEMORY_SCOPE_AGENT); }
DI unsigned xb_xcc_id() { return (unsigned)__builtin_amdgcn_s_getreg((3 << 11) | 20) & 0xFu; }
#define XB_SPIN(cond, bar) do { unsigned _sp = 0; while (cond) { __builtin_amdgcn_s_sleep(1); \
    if ((++_sp & 255u) == 0u) { if (xb_ld(&(bar)[XB_TMO])) break; if (_sp > XB_SPIN_CAP) { atomicAdd(&(bar)[XB_TMO], 1u); break; } } } } while (0)
struct XcdBarrier { unsigned* bar; unsigned x; volatile LAS unsigned* st; };
DI XcdBarrier xcd_barrier_post(unsigned* bar, volatile LAS unsigned* st) {
    XcdBarrier b; b.bar = bar; b.x = xb_xcc_id(); b.st = st;
    if (threadIdx.x == 0) st[2] = xb_add(&bar[XB_XCNT(b.x)], 1u);
    return b;
}
DI void xcd_barrier_complete(unsigned* bar, unsigned x, unsigned& nloc, unsigned& nx) {
    const unsigned G = gridDim.x * gridDim.y * gridDim.z;
    unsigned sum, cnt, mine, sp = 0u;
    for (;;) {
        sum = 0u; cnt = 0u; mine = 0u;
#pragma unroll
        for (unsigned j = 0; j < 16; ++j) { const unsigned c = xb_ld(&bar[XB_XCNT(j)]); sum += c; cnt += (c > 0u) ? 1u : 0u; mine = (j == x) ? c : mine; }
        if (sum == G) break;
        __builtin_amdgcn_s_sleep(1);
        if ((++sp & 255u) == 0u) { if (xb_ld(&bar[XB_TMO])) break; if (sp > XB_SPIN_CAP) { atomicAdd(&bar[XB_TMO], 1u); break; } }
    }
    nloc = mine > 0u ? mine : 1u; nx = cnt > 0u ? cnt : 1u;
}
DI void xcd_barrier_census_wave0(const XcdBarrier& b) {
    const unsigned lane = threadIdx.x & 63u, G = gridDim.x * gridDim.y * gridDim.z;
    unsigned cnt, sum, sp = 0u;
    for (;;) {
        cnt = (lane < 16u) ? xb_ld(&b.bar[XB_XCNT(lane)]) : 0u;
        sum = cnt;
#pragma unroll
        for (int o = 32; o >= 1; o >>= 1) sum += __shfl_xor(sum, o, 64);
        if (sum == G) break;
        __builtin_amdgcn_s_sleep(1);
        if ((++sp & 255u) == 0u) { if (xb_ld(&b.bar[XB_TMO])) break; if (sp > XB_SPIN_CAP) { if (lane == 0u) atomicAdd(&b.bar[XB_TMO], 1u); break; } }
    }
    const unsigned nx = (unsigned)__popcll(__ballot(cnt > 0u)), mine = __shfl(cnt, (int)b.x, 64);
    if (lane == 0u) { b.st[0] = mine > 0u ? mine : 1u; b.st[1] = nx > 0u ? nx : 1u; }
}
DI void xcd_barrier(const XcdBarrier& b) {
    asm volatile("s_waitcnt vmcnt(0)" ::: "memory");
    __syncthreads();
    if (threadIdx.x < 64 && b.st[0] == 0u) xcd_barrier_census_wave0(b);
    if (threadIdx.x == 0) {
        unsigned* bar = b.bar;
        __builtin_amdgcn_s_waitcnt(0);
        unsigned nloc = b.st[0], nx = b.st[1];
        if (nloc == 0u) { xcd_barrier_complete(bar, b.x, nloc, nx); b.st[0] = nloc; b.st[1] = nx; }
        const unsigned old = xb_add(&bar[XB_XSUB(b.x)], 1u);
        const unsigned gen = old / nloc;
        if (old + 1u == (gen + 1u) * nloc) {
            __builtin_amdgcn_fence(__ATOMIC_RELEASE, "agent");
            asm volatile("s_waitcnt vmcnt(0)" ::: "memory");
            const unsigned og = xb_add(&bar[XB_TOP], 1u);
            const unsigned tg = og / nx;
            if (og + 1u == (tg + 1u) * nx) xb_add(&bar[XB_TOPGEN], 1u);
            else XB_SPIN(xb_ld(&bar[XB_TOPGEN]) == tg, bar);
            __builtin_amdgcn_fence(__ATOMIC_ACQUIRE, "agent");
            xb_add(&bar[XB_XGEN(b.x)], 1u);
            asm volatile("s_waitcnt vmcnt(0)" ::: "memory");
        } else {
            XB_SPIN(xb_ld(&bar[XB_XGEN(b.x)]) == gen, bar);
            __builtin_amdgcn_fence(__ATOMIC_ACQUIRE, "agent");
            asm volatile("s_waitcnt vmcnt(0)" ::: "memory");
        }
    }
    __syncthreads();
}

struct Args {
    const float* in[27];
    float* out;
    unsigned char* ws;
    int use_cg, pad;
};
struct Ctx {
    LAS unsigned char* lds; unsigned ldsb;
    int tid, lane, wave, bid, nb;
};

DI Ctx mk(const Ctx& c0) {
    Ctx c = c0; int t = threadIdx.x; asm volatile("" : "+v"(t)); int b = c0.bid, n = c0.nb; asm volatile("" : "+s"(b), "+s"(n));
    c.tid = t; c.lane = t & 63; c.wave = __builtin_amdgcn_readfirstlane(t >> 6); c.bid = b; c.nb = n; return c;
}
DI void run_gemm(const Ctx& c0, const bf16_t* A, int lda, const bf16_t* Bt, int N, int K, int mode, bf16_t* O, bf16_t* HB, const float* ssq_in, float* ssq_out, float* vstat) {
    const Ctx c = mk(c0);
    pg8::Gemm g{A, Bt, T, N, K, lda};
    pg8::StaticOrder S; S.init(T, N, c.nb, c.bid);
    LAS float* tab = (LAS float*)(c.lds + pg8::STAGE_BYTES);
    if (mode != 3) {
        pg8::Unit u;
        if (S.next(c.tid >> 7, u)) {
#pragma unroll
            for (int k = 0; k < 2; ++k) { const int r = (c.tid & 127) + 128 * k; const f32x4* sp = (const f32x4*)(ssq_in + (size_t)(u.pm * 256 + r) * 16);
                const f32x4 s4 = (sp[0] + sp[1]) + (sp[2] + sp[3]);
                tab[(c.tid >> 7) * 256 + r] = rsqrtf((s4[0] + s4[1] + s4[2] + s4[3]) * (1.0f / 1024.f) + 1e-6f); }
        }
        __syncthreads();
    }
    pg8::gemm_phase<pg8::EpiAny, pg8::StaticOrder>(c.lds, g, S, pg8::EpiAny{mode, O, HB, tab, ssq_out, vstat}, c.tid);
    __syncthreads();
}

DI void convert_wT(const Ctx& c0, const float* __restrict__ W, bf16_t* __restrict__ Wt, int K, int N, const float* __restrict__ gain) {
    const Ctx c = mk(c0);
    LAS float* tile = (LAS float*)c.lds;
    const int tn = N / 64, ntile = (K / 64) * tn;
    const int r0 = c.tid >> 4, c4 = (c.tid & 15) * 4;
    float4 v[2]; float gk[2] = {1.f, 1.f};
#define CV_LOAD(IT) do { const int k0_ = ((IT) / tn) * 64, n0_ = ((IT) % tn) * 64; \
        _Pragma("unroll") for (int p = 0; p < 2; ++p) { v[p] = *(const float4*)(W + (size_t)(k0_ + r0 + 32 * p) * N + n0_ + c4); gk[p] = gain ? gain[k0_ + r0 + 32 * p] : 1.f; } } while (0)
    if (c.bid < ntile) CV_LOAD(c.bid);
    for (int it = c.bid; it < ntile; it += c.nb) {
        const int k0 = (it / tn) * 64, n0 = (it % tn) * 64;
#pragma unroll
        for (int p = 0; p < 2; ++p) {
            const int r = r0 + 32 * p;
            tile[r * 65 + c4 + 0] = v[p].x * gk[p]; tile[r * 65 + c4 + 1] = v[p].y * gk[p]; tile[r * 65 + c4 + 2] = v[p].z * gk[p]; tile[r * 65 + c4 + 3] = v[p].w * gk[p];
        }
        if (it + c.nb < ntile) CV_LOAD(it + c.nb);
        LDS_BAR();
        const int n = c.tid >> 3, kg = c.tid & 7;
        u32x4 w;
        w.x = pack2(tile[(kg * 8 + 0) * 65 + n], tile[(kg * 8 + 1) * 65 + n]);
        w.y = pack2(tile[(kg * 8 + 2) * 65 + n], tile[(kg * 8 + 3) * 65 + n]);
        w.z = pack2(tile[(kg * 8 + 4) * 65 + n], tile[(kg * 8 + 5) * 65 + n]);
        w.w = pack2(tile[(kg * 8 + 6) * 65 + n], tile[(kg * 8 + 7) * 65 + n]);
        *(u32x4*)(Wt + (size_t)(n0 + n) * K + k0 + kg * 8) = w;
        LDS_BAR();
    }
#undef CV_LOAD
    __syncthreads();
}

DI void prologue_phase(const Ctx& c0, const float* src, bf16_t* dst, float* ssqA) {
    const Ctx c = mk(c0);
    for (int rowb = c.bid * 8 + c.wave; rowb < T; rowb += 2 * c.nb * 8) {
        float4 v[2][4];
#pragma unroll
        for (int k = 0; k < 2; ++k) { const int row = rowb + k * c.nb * 8; if (row < T) {
#pragma unroll
            for (int i = 0; i < 4; ++i) v[k][i] = ((const float4*)(src + (size_t)row * DM))[c.lane + 64 * i]; } }
#pragma unroll
        for (int k = 0; k < 2; ++k) { const int row = rowb + k * c.nb * 8; if (row < T) {
            float ss = 0.f;
#pragma unroll
            for (int i = 0; i < 4; ++i) {
                u32x2 w; w.x = pack2(v[k][i].x, v[k][i].y); w.y = pack2(v[k][i].z, v[k][i].w);
                *(u32x2*)(dst + (size_t)row * DM + (c.lane + 64 * i) * 4) = w;
                const float r0 = lo_f(w.x), r1 = hi_f(w.x), r2 = lo_f(w.y), r3 = hi_f(w.y);
                ss += r0 * r0 + r1 * r1 + r2 * r2 + r3 * r3;
            }
            ss = wave_sum(ss);
            if (c.lane < 16) ssqA[row * 16 + c.lane] = (c.lane == 0) ? ss : 0.f; } }
    }
}
DI void final_norm_phase(const Ctx& c0, const bf16_t* hb, float* out, const float* __restrict__ g, const float* ssq) {
    const Ctx c = mk(c0);
    constexpr int NCH = T * DM / 8, STRIDE = 256 * NTHR;
    for (int i0 = c.bid * NTHR + c.tid; i0 < NCH; i0 += 4 * c.nb * NTHR) {
        const int gi = ((c.bid * NTHR + c.tid) & 127) * 2;
        const float4 g0 = ((const float4*)g)[gi], g1 = ((const float4*)g)[gi + 1];
        u32x4 w[4]; f32x4 sa[4], sb[4], sc[4], sd[4];
#pragma unroll
        for (int k = 0; k < 4; ++k) { const int i = i0 + k * c.nb * NTHR; if (i < NCH) { w[k] = ((const u32x4*)hb)[i]; const f32x4* sp = (const f32x4*)(ssq + (i >> 7) * 16); sa[k] = sp[0]; sb[k] = sp[1]; sc[k] = sp[2]; sd[k] = sp[3]; } }
#pragma unroll
        for (int k = 0; k < 4; ++k) { const int i = i0 + k * c.nb * NTHR; if (i < NCH) {
            const f32x4 s4 = (sa[k] + sb[k]) + (sc[k] + sd[k]);
            const float r = rsqrtf((s4[0] + s4[1] + s4[2] + s4[3]) * (1.0f / DM) + 1e-6f);
            float4 o0, o1;
            o0.x = lo_f(w[k].x) * r * g0.x; o0.y = hi_f(w[k].x) * r * g0.y; o0.z = lo_f(w[k].y) * r * g0.z; o0.w = hi_f(w[k].y) * r * g0.w;
            o1.x = lo_f(w[k].z) * r * g1.x; o1.y = hi_f(w[k].z) * r * g1.y; o1.z = lo_f(w[k].w) * r * g1.z; o1.w = hi_f(w[k].w) * r * g1.w;
            ((float4*)out)[2 * i] = o0; ((float4*)out)[2 * i + 1] = o1; } }
    }
    (void)STRIDE;
}

DI void gmlp_stats_phase(const Ctx& c0, const bf16_t* big, float* stats) {
    const Ctx c = mk(c0);
    for (int row = c.bid * 8 + c.wave; row < T; row += c.nb * 8) {
        const u32x4* p = (const u32x4*)(big + (size_t)row * 4096 + 2048);
        float x[32]; float s = 0.f;
#pragma unroll
        for (int i = 0; i < 4; ++i) { const u32x4 w = p[c.lane + 64 * i];
            x[i * 8 + 0] = lo_f(w.x); x[i * 8 + 1] = hi_f(w.x); x[i * 8 + 2] = lo_f(w.y); x[i * 8 + 3] = hi_f(w.y);
            x[i * 8 + 4] = lo_f(w.z); x[i * 8 + 5] = hi_f(w.z); x[i * 8 + 6] = lo_f(w.w); x[i * 8 + 7] = hi_f(w.w); }
#pragma unroll
        for (int i = 0; i < 32; ++i) s += x[i];
        const float mean = wave_sum(s) * (1.0f / 2048.f);
        float q = 0.f;
#pragma unroll
        for (int i = 0; i < 32; ++i) { const float d = x[i] - mean; q += d * d; }
        q = wave_sum(q);
        if (c.lane == 0) { stats[2 * row] = mean; stats[2 * row + 1] = rsqrtf(q * (1.0f / 2048.f) + 1e-6f); }
    }
}
DI void gmlp_spatial_phase(const Ctx& c0, bf16_t* big, const float* vstat, const float* __restrict__ ws_, const float* __restrict__ bs_, const float* __restrict__ lng, const float* __restrict__ lnb) {
    const Ctx c = mk(c0);
    constexpr int P = 272;
    constexpr unsigned WS_O = 0, VS_O = 128 * P, ST_O = 256 * P;
    LAS float* ST = (LAS float*)(c.lds + ST_O);
    const int lane = c.lane, w = c.wave;
    int g_loaded = -1;
    for (int it = c.bid; it < 2048; it += c.nb) {
        const int chunk = it >> 4, g = it & 15;
        const int sr = c.tid >> 2, sq = c.tid & 3;
        const f32x4* stp = (const f32x4*)(vstat + ((size_t)(chunk * 128 + sr) * 32 + sq * 8) * 2);
        const f32x4 a0 = stp[0], a1 = stp[1], a2 = stp[2], a3 = stp[3];
        u32x4 vraw[4];
#pragma unroll
        for (int i = 0; i < 4; ++i) { const int idx = c.tid + 512 * i, s = idx >> 4, d8 = (idx & 15) * 8;
            vraw[i] = *(const u32x4*)(big + (size_t)(chunk * 128 + s) * 4096 + 2048 + g * 128 + d8); }
        const int t0 = 16 * w, t = t0 + (lane & 15), row = chunk * 128 + t, g4 = lane >> 4;
        u32x2 uraw[8];
#pragma unroll
        for (int dt = 0; dt < 8; ++dt) uraw[dt] = *(const u32x2*)(big + (size_t)row * 4096 + g * 128 + 16 * dt + 4 * g4);
        const float bsv = bs_[g * 128 + t];
        const int lcol = g * 128 + (c.tid & 15) * 8;
        const float4 g0 = *(const float4*)(lng + lcol), g1 = *(const float4*)(lng + lcol + 4), b0 = *(const float4*)(lnb + lcol), b1 = *(const float4*)(lnb + lcol + 4);
        if (g != g_loaded) {
            const float* Wg = ws_ + (size_t)g * 128 * 128;
            float4 wv8[8];
#pragma unroll
            for (int i = 0; i < 8; ++i) { const int idx = c.tid + 512 * i; wv8[i] = *(const float4*)(Wg + (idx >> 5) * 128 + (idx & 31) * 4); }
#pragma unroll
            for (int i = 0; i < 8; ++i) {
                const int idx = c.tid + 512 * i, tt = idx >> 5, s4 = (idx & 31) * 4;
                const float4 v = wv8[i];
                u32x2 o; o.x = pack2(s4 + 0 <= tt ? v.x : 0.f, s4 + 1 <= tt ? v.y : 0.f); o.y = pack2(s4 + 2 <= tt ? v.z : 0.f, s4 + 3 <= tt ? v.w : 0.f);
                *(LAS u32x2*)(c.lds + WS_O + tt * P + s4 * 2) = o;
            }
            g_loaded = g;
        }
        {
            float s1 = (a0[0] + a0[2]) + (a1[0] + a1[2]) + (a2[0] + a2[2]) + (a3[0] + a3[2]);
            float s2 = (a0[1] + a0[3]) + (a1[1] + a1[3]) + (a2[1] + a2[3]) + (a3[1] + a3[3]);
            s1 += __shfl_xor(s1, 1, 64); s1 += __shfl_xor(s1, 2, 64); s2 += __shfl_xor(s2, 1, 64); s2 += __shfl_xor(s2, 2, 64);
            const float mean = s1 * (1.0f / 2048.f), var = fmaxf(s2 * (1.0f / 2048.f) - mean * mean, 0.f);
            if (sq == 0) { ST[2 * sr] = mean; ST[2 * sr + 1] = rsqrtf(var + 1e-6f); }
        }
        __syncthreads();
#pragma unroll
        for (int i = 0; i < 4; ++i) {
            const int idx = c.tid + 512 * i, s = idx >> 4, d8 = (idx & 15) * 8;
            const int col = g * 128 + d8;
            const u32x4 raw = vraw[i];
            const float mean = ST[2 * s], rstd = ST[2 * s + 1];
            u32x4 o;
            o.x = pack2((lo_f(raw.x) - mean) * rstd * g0.x + b0.x, (hi_f(raw.x) - mean) * rstd * g0.y + b0.y);
            o.y = pack2((lo_f(raw.y) - mean) * rstd * g0.z + b0.z, (hi_f(raw.y) - mean) * rstd * g0.w + b0.w);
            o.z = pack2((lo_f(raw.z) - mean) * rstd * g1.x + b1.x, (hi_f(raw.z) - mean) * rstd * g1.y + b1.y);
            o.w = pack2((lo_f(raw.w) - mean) * rstd * g1.z + b1.z, (hi_f(raw.w) - mean) * rstd * g1.w + b1.w);
            *(LAS u32x4*)(c.lds + VS_O + s * P + d8 * 2) = o;
        }
        __syncthreads();
        f32x4 acc[8];
#pragma unroll
        for (int dt = 0; dt < 8; ++dt) acc[dt] = (f32x4){0.f, 0.f, 0.f, 0.f};
        for (int s0 = 0; s0 <= t0 + 15; s0 += 32) {
            const bf16x8 y = row_load(c.lds, WS_O, P, t0, s0, lane);
            const unsigned ta = tr_addr(c.ldsb + VS_O, P, s0, 0, lane);
#pragma unroll
            for (int dq = 0; dq < 2; ++dq) { bf16x8 x[4]; tr_load4(x, ta + 128 * dq, ta + 128 * dq + 32, ta + 128 * dq + 64, ta + 128 * dq + 96, P);
#pragma unroll
                for (int k = 0; k < 4; ++k) acc[4 * dq + k] = mfma16(x[k], y, acc[4 * dq + k]); }
        }
#pragma unroll
        for (int dt = 0; dt < 8; ++dt) {
            bf16_t* p = big + (size_t)row * 4096 + g * 128 + 16 * dt + 4 * g4;
            const u32x2 u = uraw[dt];
            u32x2 o; o.x = pack2(lo_f(u.x) * (acc[dt][0] + bsv), hi_f(u.x) * (acc[dt][1] + bsv)); o.y = pack2(lo_f(u.y) * (acc[dt][2] + bsv), hi_f(u.y) * (acc[dt][3] + bsv));
            *(u32x2*)p = o;
        }
        __syncthreads();
    }
}

DI void hgrn_local_phase(const Ctx& c0, bf16_t* big, bf16_t* states, float* dec, const float* __restrict__ lb_logits, int layer) {
    const Ctx c = mk(c0);
    constexpr int P = 272, PP = 144;
    constexpr int BP = 136;
    constexpr unsigned BC_O = 0, TOT_O = 64 * BP * 4, QM_O = TOT_O + 2048, KM_O = QM_O + 64 * P, KH_O = KM_O + 64 * P, IM_O = KH_O + 64 * P, PM_O = IM_O + 64 * P;
    LAS float* BC = (LAS float*)(c.lds + BC_O); LAS float* TOT = (LAS float*)(c.lds + TOT_O);
    LAS float* LBT = (LAS float*)(c.lds + PM_O + 64 * PP);
    const int lane = c.lane, w = c.wave, tid = c.tid;
    const int row = tid >> 3, c16 = (tid & 7) * 16;
    u32x4 qa, qb, ia, ib, fa, fb; float lb[16];
#define HL_LOAD(IT) do { const int bh_ = (IT) >> 7, ch_ = (IT) & 127, h_ = bh_ & 7; \
        const bf16_t* p_ = big + (size_t)((bh_ >> 3) * SEQ + ch_ * 64 + row) * 4096 + h_ * 128 + c16; \
        qa = *(const u32x4*)(p_); qb = *(const u32x4*)(p_ + 8); ia = *(const u32x4*)(p_ + 2048); ib = *(const u32x4*)(p_ + 2048 + 8); fa = *(const u32x4*)(p_ + 1024); fb = *(const u32x4*)(p_ + 1024 + 8); \
        _Pragma("unroll") for (int j = 0; j < 16; j += 4) { const f32x4 t4_ = *(const LAS f32x4*)(LBT + h_ * 128 + c16 + j); lb[j] = t4_[0]; lb[j + 1] = t4_[1]; lb[j + 2] = t4_[2]; lb[j + 3] = t4_[3]; } } while (0)
#pragma unroll
    for (int k = 0; k < 2; ++k) { const int d = tid + 512 * k;
        const float l0 = lb_logits[d], l1 = lb_logits[1024 + d], l2 = lb_logits[2048 + d], l3 = lb_logits[3072 + d];
        const float mx = fmaxf(fmaxf(l0, l1), fmaxf(l2, l3));
        const float e0 = __expf(l0 - mx), e1 = __expf(l1 - mx), e2 = __expf(l2 - mx), e3 = __expf(l3 - mx);
        float num = 0.f; if (layer >= 1) num += e1; if (layer >= 2) num += e2; if (layer >= 3) num += e3;
        LBT[d] = num / (e0 + e1 + e2 + e3); }
    __syncthreads();
    if (c.bid < 2048) HL_LOAD(c.bid);
    for (int it = c.bid; it < 2048; it += c.nb) {
        const int bh = it >> 7, ch = it & 127, b = bh >> 3, h = bh & 7;
        const int r0 = b * SEQ + ch * 64;
        bf16_t* prow = big + (size_t)(r0 + row) * 4096 + h * 128 + c16;
        float xf[16];
        { const u32x4 a = fa, bq = fb;
          xf[0] = lo_f(a.x); xf[1] = hi_f(a.x); xf[2] = lo_f(a.y); xf[3] = hi_f(a.y); xf[4] = lo_f(a.z); xf[5] = hi_f(a.z); xf[6] = lo_f(a.w); xf[7] = hi_f(a.w);
          xf[8] = lo_f(bq.x); xf[9] = hi_f(bq.x); xf[10] = lo_f(bq.y); xf[11] = hi_f(bq.y); xf[12] = lo_f(bq.z); xf[13] = hi_f(bq.z); xf[14] = lo_f(bq.w); xf[15] = hi_f(bq.w); }
#pragma unroll
        for (int j = 0; j < 16; ++j) { const float f = lb[j] + (1.0f - lb[j]) * sigmoidf_(xf[j]); BC[row * BP + j * 8 + (tid & 7)] = __logf(f); xf[j] = 1.0f - f; }
        __syncthreads();
        {
            const int d = tid & 127, seg = tid >> 7;
            float pre[16]; float run = 0.f;
#pragma unroll
            for (int j = 0; j < 16; ++j) { run += BC[(seg * 16 + j) * BP + d]; pre[j] = run; }
            TOT[seg * 128 + d] = run;
            __syncthreads();
            float off = 0.f;
            for (int s = 0; s < seg; ++s) off += TOT[s * 128 + d];
#pragma unroll
            for (int j = 0; j < 16; ++j) BC[(seg * 16 + j) * BP + d] = pre[j] + off;
        }
        __syncthreads();
        {
            float qv[16], iv_dummy;
            (void)iv_dummy;
            qv[0] = lo_f(qa.x); qv[1] = hi_f(qa.x); qv[2] = lo_f(qa.y); qv[3] = hi_f(qa.y); qv[4] = lo_f(qa.z); qv[5] = hi_f(qa.z); qv[6] = lo_f(qa.w); qv[7] = hi_f(qa.w);
            qv[8] = lo_f(qb.x); qv[9] = hi_f(qb.x); qv[10] = lo_f(qb.y); qv[11] = hi_f(qb.y); qv[12] = lo_f(qb.z); qv[13] = hi_f(qb.z); qv[14] = lo_f(qb.w); qv[15] = hi_f(qb.w);
            unsigned qm[8], km[8], kh[8], qi[8];
#pragma unroll
            for (int j = 0; j < 16; j += 2) {
                float o[2][4];
#pragma unroll
                for (int e = 0; e < 2; ++e) {
                    const int d = (j + e) * 8 + (tid & 7);
                    const float bc = BC[row * BP + d], bm = BC[31 * BP + d], bl = BC[63 * BP + d];
                    const float qs = siluf_(qv[j + e]);
                    const float kk = xf[j + e];
                    o[e][0] = qs * __expf(bc - bm); o[e][1] = kk * __expf(bm - bc); o[e][2] = kk * __expf(bl - bc); o[e][3] = qs * __expf(bc);
                }
                qm[j >> 1] = pack2(o[0][0], o[1][0]); km[j >> 1] = pack2(o[0][1], o[1][1]); kh[j >> 1] = pack2(o[0][2], o[1][2]); qi[j >> 1] = pack2(o[0][3], o[1][3]);
            }
            const unsigned off = row * P + c16 * 2;
            *(LAS u32x4*)(c.lds + QM_O + off) = (u32x4){qm[0], qm[1], qm[2], qm[3]}; *(LAS u32x4*)(c.lds + QM_O + off + 16) = (u32x4){qm[4], qm[5], qm[6], qm[7]};
            *(LAS u32x4*)(c.lds + KM_O + off) = (u32x4){km[0], km[1], km[2], km[3]}; *(LAS u32x4*)(c.lds + KM_O + off + 16) = (u32x4){km[4], km[5], km[6], km[7]};
            *(LAS u32x4*)(c.lds + KH_O + off) = (u32x4){kh[0], kh[1], kh[2], kh[3]}; *(LAS u32x4*)(c.lds + KH_O + off + 16) = (u32x4){kh[4], kh[5], kh[6], kh[7]};
            *(LAS u32x4*)(c.lds + IM_O + off) = ia; *(LAS u32x4*)(c.lds + IM_O + off + 16) = ib;
            *(u32x4*)(prow) = (u32x4){qi[0], qi[1], qi[2], qi[3]}; *(u32x4*)(prow + 8) = (u32x4){qi[4], qi[5], qi[6], qi[7]};
            if (tid < 128) dec[(size_t)it * 128 + tid] = __expf(BC[63 * BP + (tid & 15) * 8 + (tid >> 4)]);
        }
        __syncthreads();
        if (it + c.nb < 2048) HL_LOAD(it + c.nb);
        {
            const int ti = w >> 1;
#pragma unroll
            for (int k2 = 0; k2 < 2; ++k2) {
                const int si = 2 * (w & 1) + k2;
                f32x4 acc = (f32x4){0.f, 0.f, 0.f, 0.f};
                if (si <= ti) {
#pragma unroll
                    for (int d0 = 0; d0 < 128; d0 += 32) { const bf16x8 x = row_load(c.lds, QM_O, P, 16 * ti, d0, lane), y = row_load(c.lds, KM_O, P, 16 * si, d0, lane); acc = mfma16(x, y, acc); }
                }
                const int s = 16 * si + (lane & 15);
#pragma unroll
                for (int e = 0; e < 4; ++e) { const int t = 16 * ti + 4 * (lane >> 4) + e;
                    *(LAS bf16_t*)(c.lds + PM_O + t * PP + s * 2) = (bf16_t)((si <= ti && s <= t) ? f2bf(acc[e]) : 0u); }
            }
        }
        __syncthreads();
        {
            const int t0 = 16 * (w >> 1);
            const bf16x8 y0 = row_load(c.lds, PM_O, PP, t0, 0, lane), y1 = row_load(c.lds, PM_O, PP, t0, 32, lane);
            const int t = t0 + (lane & 15);
            bf16x8 xi0[4], xi1[4];
            { const unsigned ta = tr_addr(c.ldsb + IM_O, P, 0, 64 * (w & 1), lane); tr_load4(xi0, ta, ta + 32, ta + 64, ta + 96, P); tr_load4(xi1, ta + 32 * P, ta + 32 * P + 32, ta + 32 * P + 64, ta + 32 * P + 96, P); }
#pragma unroll
            for (int k4 = 0; k4 < 4; ++k4) {
                const int v0 = 16 * (4 * (w & 1) + k4);
                f32x4 acc = (f32x4){0.f, 0.f, 0.f, 0.f};
                acc = mfma16(xi0[k4], y0, acc);
                acc = mfma16(xi1[k4], y1, acc);
                u32x2 o; o.x = pack2(acc[0], acc[1]); o.y = pack2(acc[2], acc[3]);
                *(u32x2*)(big + (size_t)(r0 + t) * 4096 + 1024 + h * 128 + v0 + 4 * (lane >> 4)) = o;
            }
        }
        {
            const int v0 = 16 * w;
            const bf16x8 x0 = tr_load(c.ldsb + IM_O, P, 0, v0, lane), x1 = tr_load(c.ldsb + IM_O, P, 32, v0, lane);
            bf16_t* Sg = states + (size_t)it * 16384;
            const unsigned tk = tr_addr(c.ldsb + KH_O, P, 0, 0, lane);
#pragma unroll
            for (int dq = 0; dq < 2; ++dq) {
                bf16x8 ya[4], yb[4];
                tr_load4(ya, tk + 128 * dq, tk + 128 * dq + 32, tk + 128 * dq + 64, tk + 128 * dq + 96, P);
                tr_load4(yb, tk + 32 * P + 128 * dq, tk + 32 * P + 128 * dq + 32, tk + 32 * P + 128 * dq + 64, tk + 32 * P + 128 * dq + 96, P);
#pragma unroll
                for (int k = 0; k < 4; ++k) { const int dt = 4 * dq + k;
                    f32x4 acc = (f32x4){0.f, 0.f, 0.f, 0.f};
                    acc = mfma16(x0, ya[k], acc);
                    acc = mfma16(x1, yb[k], acc);
                    u32x2 o; o.x = pack2(acc[0], acc[1]); o.y = pack2(acc[2], acc[3]);
                    *(u32x2*)(Sg + (16 * dt + (lane & 15)) * 128 + v0 + 4 * (lane >> 4)) = o; }
            }
        }
        LDS_BAR();
    }
#undef HL_LOAD
}
DI void hgrn_scan_phase(const Ctx& c0, bf16_t* states, const float* dec) {
    const Ctx c = mk(c0);
    for (int gid = c.bid * NTHR + c.tid; gid < 16 * 8192; gid += c.nb * NTHR) {
        const int bh = gid >> 13, pr = gid & 8191, d = pr >> 6;
        unsigned* p = (unsigned*)(states + (size_t)bh * 128 * 16384) + pr;
        const float* dp = dec + (size_t)bh * 128 * 128 + d;
        float s0 = 0.f, s1 = 0.f;
        for (int cb = 0; cb < 128; cb += 4) {
            unsigned dv[4]; float dc[4];
#pragma unroll
            for (int j = 0; j < 4; ++j) { dv[j] = p[(size_t)(cb + j) * 8192]; dc[j] = dp[(cb + j) * 128]; }
#pragma unroll
            for (int j = 0; j < 4; ++j) { const unsigned o = pack2(s0, s1); s0 = dc[j] * s0 + lo_f(dv[j]); s1 = dc[j] * s1 + hi_f(dv[j]); dv[j] = o; }
#pragma unroll
            for (int j = 0; j < 4; ++j) p[(size_t)(cb + j) * 8192] = dv[j];
        }
    }
}
DI void hgrn_out_phase(const Ctx& c0, bf16_t* big, const bf16_t* states, const float* __restrict__ norm_g) {
    const Ctx c = mk(c0);
    constexpr int P = 272;
    constexpr unsigned SM_O = 0, QI_O = 128 * P, RED_O = QI_O + 64 * P;
    LAS float* RED = (LAS float*)(c.lds + RED_O);
    const int lane = c.lane, w = c.wave, tid = c.tid;
    for (int it = c.bid; it < 2048; it += c.nb) {
        const int bh = it >> 7, ch = it & 127, b = bh >> 3, h = bh & 7;
        const int r0 = b * SEQ + ch * 64;
        const bf16_t* Sg = states + (size_t)it * 16384;
        u32x4 sld[4], qld[2];
#pragma unroll
        for (int i = 0; i < 4; ++i) { const int idx = tid + 512 * i; sld[i] = *(const u32x4*)(Sg + (idx >> 4) * 128 + (idx & 15) * 8); }
#pragma unroll
        for (int i = 0; i < 2; ++i) { const int idx = tid + 512 * i; qld[i] = *(const u32x4*)(big + (size_t)(r0 + (idx >> 4)) * 4096 + h * 128 + (idx & 15) * 8); }
        const int t0 = 16 * (w & 3), vh = w >> 2;
        const int t = t0 + (lane & 15), g4 = lane >> 4;
        bf16_t* prow = big + (size_t)(r0 + t) * 4096 + h * 128;
        u32x2 oiv[4], gvv[4];
#pragma unroll
        for (int k4 = 0; k4 < 4; ++k4) { const int v = 16 * (4 * vh + k4) + 4 * g4; oiv[k4] = *(const u32x2*)(prow + 1024 + v); gvv[k4] = *(const u32x2*)(prow + 3072 + v); }
        float4 ngv[4];
#pragma unroll
        for (int k4 = 0; k4 < 4; ++k4) ngv[k4] = *(const float4*)(norm_g + h * 128 + 16 * (4 * vh + k4) + 4 * g4);
#pragma unroll
        for (int i = 0; i < 4; ++i) { const int idx = tid + 512 * i; *(LAS u32x4*)(c.lds + SM_O + (idx >> 4) * P + (idx & 15) * 16) = sld[i]; }
#pragma unroll
        for (int i = 0; i < 2; ++i) { const int idx = tid + 512 * i; *(LAS u32x4*)(c.lds + QI_O + (idx >> 4) * P + (idx & 15) * 16) = qld[i]; }
        __syncthreads();
        f32x4 acc[4];
#pragma unroll
        for (int k4 = 0; k4 < 4; ++k4) acc[k4] = (f32x4){0.f, 0.f, 0.f, 0.f};
#pragma unroll
        for (int d0 = 0; d0 < 128; d0 += 32) {
            const bf16x8 y = row_load(c.lds, QI_O, P, t0, d0, lane);
            bf16x8 x[4]; { const unsigned ta = tr_addr(c.ldsb + SM_O, P, d0, 64 * vh, lane); tr_load4(x, ta, ta + 32, ta + 64, ta + 96, P); }
#pragma unroll
            for (int k4 = 0; k4 < 4; ++k4) acc[k4] = mfma16(x[k4], y, acc[k4]);
        }
        float ss = 0.f;
#pragma unroll
        for (int k4 = 0; k4 < 4; ++k4) {
            const int v = 16 * (4 * vh + k4) + 4 * g4;
            const u32x2 oi = oiv[k4];
            acc[k4][0] += lo_f(oi.x); acc[k4][1] += hi_f(oi.x); acc[k4][2] += lo_f(oi.y); acc[k4][3] += hi_f(oi.y);
            ss += acc[k4][0] * acc[k4][0] + acc[k4][1] * acc[k4][1] + acc[k4][2] * acc[k4][2] + acc[k4][3] * acc[k4][3];
        }
        ss += __shfl_xor(ss, 16, 64); ss += __shfl_xor(ss, 32, 64);
        if (g4 == 0) RED[t * 2 + vh] = ss;
        __syncthreads();
        const float rstd = rsqrtf((RED[t * 2] + RED[t * 2 + 1]) * (1.0f / 128.f) + 1e-6f);
#pragma unroll
        for (int k4 = 0; k4 < 4; ++k4) {
            const int v = 16 * (4 * vh + k4) + 4 * g4;
            const u32x2 gv = gvv[k4];
            const float4 ng = ngv[k4];
            u32x2 o;
            o.x = pack2(acc[k4][0] * rstd * ng.x * siluf_(lo_f(gv.x)), acc[k4][1] * rstd * ng.y * siluf_(hi_f(gv.x)));
            o.y = pack2(acc[k4][2] * rstd * ng.z * siluf_(lo_f(gv.y)), acc[k4][3] * rstd * ng.w * siluf_(hi_f(gv.y)));
            *(u32x2*)(prow + 3072 + v) = o;
        }
        __syncthreads();
    }
}

DI void mlstm_conv_phase(const Ctx& cx, const bf16_t* big, bf16_t* CA, float* gates, const float* __restrict__ conv_w, const float* __restrict__ conv_b,
                         const float* __restrict__ wq, const float* __restrict__ wk, const float* __restrict__ wv, const float* __restrict__ wg, const float* __restrict__ bg) {
    const Ctx c = mk(cx);
    LAS float* GS = (LAS float*)c.lds;
    const int tid = c.tid, lane = c.lane, w = c.wave;
    const int c0 = 4 * tid;
    float cw[4][4], cb[4]; f32x2 wca2[4][4], wvv2[4][4];
#pragma unroll
    for (int j = 0; j < 4; ++j) { const float4 v = *(const float4*)(conv_w + j * 2048 + c0); cw[j][0] = v.x; cw[j][1] = v.y; cw[j][2] = v.z; cw[j][3] = v.w; }
    { const float4 v = *(const float4*)(conv_b + c0); cb[0] = v.x; cb[1] = v.y; cb[2] = v.z; cb[3] = v.w; }
#pragma unroll
    for (int d = 0; d < 4; ++d)
#pragma unroll
        for (int gi = 0; gi < 8; ++gi) { float a = 0.f, bsum = 0.f;
#pragma unroll
            for (int e = 0; e < 4; ++e) {
                a += wq[tid * 16 + d * 4 + e] * wg[(size_t)(c0 + e) * 8 + gi] + wk[tid * 16 + d * 4 + e] * wg[(size_t)(2048 + c0 + e) * 8 + gi];
                bsum += wv[tid * 16 + d * 4 + e] * wg[(size_t)(4096 + c0 + e) * 8 + gi]; }
            if (gi & 1) { wca2[d][gi >> 1].y = a; wvv2[d][gi >> 1].y = bsum; } else { wca2[d][gi >> 1].x = a; wvv2[d][gi >> 1].x = bsum; } }
    for (int it = c.bid; it < T / 16; it += c.nb) {
        const int r0 = it * 16;
        const bool first = (r0 % SEQ) == 0;
        u32x2 xs[19];
#pragma unroll
        for (int j = 0; j < 3; ++j) xs[j] = first ? (u32x2){0u, 0u} : *(const u32x2*)(big + (size_t)(r0 - 3 + j) * 4096 + c0);
#pragma unroll
        for (int j = 0; j < 16; ++j) xs[3 + j] = *(const u32x2*)(big + (size_t)(r0 + j) * 4096 + c0);
#pragma unroll
        for (int tt = 0; tt < 16; ++tt) {
            float x[4][4];
#pragma unroll
            for (int j = 0; j < 4; ++j) { x[j][0] = lo_f(xs[tt + j].x); x[j][1] = hi_f(xs[tt + j].x); x[j][2] = lo_f(xs[tt + j].y); x[j][3] = hi_f(xs[tt + j].y); }
            float ca[4];
#pragma unroll
            for (int e = 0; e < 4; ++e) ca[e] = siluf_(cb[e] + cw[0][e] * x[0][e] + cw[1][e] * x[1][e] + cw[2][e] * x[2][e] + cw[3][e] * x[3][e]);
            u32x2 o; o.x = pack2(ca[0], ca[1]); o.y = pack2(ca[2], ca[3]);
            *(u32x2*)(CA + (size_t)(r0 + tt) * 2048 + c0) = o;
            float p[8];
            {
                f32x2 p2[4];
#pragma unroll
                for (int g2 = 0; g2 < 4; ++g2) p2[g2] = (f32x2){0.f, 0.f};
#pragma unroll
                for (int e = 0; e < 4; ++e) { const f32x2 cb2 = (f32x2){ca[e], ca[e]}, xb2 = (f32x2){x[3][e], x[3][e]};
#pragma unroll
                    for (int g2 = 0; g2 < 4; ++g2) { p2[g2] = __builtin_elementwise_fma(wca2[e][g2], cb2, p2[g2]); p2[g2] = __builtin_elementwise_fma(wvv2[e][g2], xb2, p2[g2]); } }
#pragma unroll
                for (int g2 = 0; g2 < 4; ++g2) { p[2 * g2] = p2[g2].x; p[2 * g2 + 1] = p2[g2].y; }
            }
            const bool h1 = (lane & 32) != 0, h2 = (lane & 16) != 0, h3 = (lane & 8) != 0;
            float q4[4], r2[2];
#pragma unroll
            for (int j = 0; j < 4; ++j) { const float send = h1 ? p[j] : p[j + 4], keep = h1 ? p[j + 4] : p[j]; q4[j] = keep + __shfl_xor(send, 32, 64); }
#pragma unroll
            for (int j = 0; j < 2; ++j) { const float send = h2 ? q4[j] : q4[j + 2], keep = h2 ? q4[j + 2] : q4[j]; r2[j] = keep + __shfl_xor(send, 16, 64); }
            float s;
            { const float send = h3 ? r2[0] : r2[1], keep = h3 ? r2[1] : r2[0]; s = keep + __shfl_xor(send, 8, 64); }
            s += __shfl_xor(s, 4, 64); s += __shfl_xor(s, 2, 64); s += __shfl_xor(s, 1, 64);
            if ((lane & 7) == 0) GS[(w * 16 + tt) * 8 + (lane >> 3)] = s;
        }
        __syncthreads();
        if (tid < 128) { float a = bg[tid & 7];
#pragma unroll
            for (int ww = 0; ww < 8; ++ww) a += GS[ww * 128 + tid];
            gates[(size_t)r0 * 8 + tid] = a; }
        __syncthreads();
    }
}
struct QKW { float k[16]; };
DI void load_qkw(QKW& W, const float* __restrict__ wq, const float* __restrict__ wk, int h, int tid) {
    const int nb0 = h * 128 + (tid & 127);
#pragma unroll
    for (int cc = 0; cc < 4; ++cc)
#pragma unroll
        for (int d = 0; d < 4; ++d) { float a = 0.f;
#pragma unroll
            for (int e = 0; e < 4; ++e) a += wk[nb0 * 16 + cc * 4 + e] * wq[nb0 * 16 + d * 4 + e];
            W.k[cc * 4 + d] = a * 0.04419417382415922f; }
}
DI void qk_to_lds(LAS unsigned char* lds, unsigned q_o, unsigned k_o, const QKW& W, const u32x2 raw, int t, int cb) {
    const float x[4] = {lo_f(raw.x), hi_f(raw.x), lo_f(raw.y), hi_f(raw.y)};
    float k[4];
#pragma unroll
    for (int e = 0; e < 4; ++e) { float bsum = 0.f;
#pragma unroll
        for (int d = 0; d < 4; ++d) bsum += x[d] * W.k[d * 4 + e];
        k[e] = bsum; }
    const unsigned off = t * 1040 + cb * 8;
    *(LAS u32x2*)(lds + q_o + off) = raw;
    *(LAS u32x2*)(lds + k_o + off) = (u32x2){pack2(k[0], k[1]), pack2(k[2], k[3])};
}
DI void mlstm_smat_phase(const Ctx& c0, const bf16_t* CA, const float* gates, float* scal, bf16_t* Sg, const float* __restrict__ wq, const float* __restrict__ wk) {
    const Ctx c = mk(c0);
    constexpr int P = 1040;
    constexpr unsigned Q_O = 0, K_O = 64 * P, SC_O = 128 * P;
    LAS float* SC = (LAS float*)(c.lds + SC_O);
    const int lane = c.lane, w = c.wave, tid = c.tid;
    for (int it = c.bid; it < 1024; it += c.nb) {
        const int bh = it >> 7, ch = it & 127, b = bh >> 2, h = bh & 3;
        const int r0 = b * SEQ + ch * 64;
        if (w == 0) {
            const float gi = gates[(size_t)(r0 + lane) * 8 + h], gf = gates[(size_t)(r0 + lane) * 8 + 4 + h];
            const float lf = fminf(gf, 0.f) - log1pf(__expf(-fabsf(gf)));
            float a = lf;
#pragma unroll
            for (int o = 1; o < 64; o <<= 1) { const float v = __shfl_up(a, o, 64); if (lane >= o) a += v; }
            float pm = gi - a;
#pragma unroll
            for (int o = 1; o < 64; o <<= 1) { const float v = __shfl_up(pm, o, 64); if (lane >= o) pm = fmaxf(pm, v); }
            const float mloc = a + pm;
            const float alast = __shfl(a, 63, 64);
            const float gmax = wave_max(alast - a + gi);
            SC[lane] = a; SC[64 + lane] = gi; SC[128 + lane] = mloc;
            float* sp = scal + (size_t)it * 256;
            sp[lane] = a; sp[64 + lane] = gi; sp[128 + lane] = mloc; sp[192 + lane] = (lane == 0) ? gmax : alast;
        }
        QKW W; load_qkw(W, wq, wk, h, tid);
        {
            const int cb = tid & 127, tb = tid >> 7;
            u32x2 raw[16];
#pragma unroll
            for (int i = 0; i < 16; ++i) raw[i] = *(const u32x2*)(CA + (size_t)(r0 + tb + 4 * i) * 2048 + h * 512 + cb * 4);
#pragma unroll
            for (int i = 0; i < 16; ++i) qk_to_lds(c.lds, Q_O, K_O, W, raw[i], tb + 4 * i, cb);
        }
        __syncthreads();
        const int ti = w >> 1;
        bf16_t* So = Sg + (size_t)it * 4096;
#pragma unroll
        for (int k2 = 0; k2 < 2; ++k2) {
            const int si = 2 * (w & 1) + k2;
            f32x4 acc = (f32x4){0.f, 0.f, 0.f, 0.f};
            if (si <= ti) {
#pragma unroll 4
                for (int d0 = 0; d0 < 512; d0 += 32) { const bf16x8 x = row_load(c.lds, K_O, P, 16 * si, d0, lane), y = row_load(c.lds, Q_O, P, 16 * ti, d0, lane); acc = mfma16(x, y, acc); }
            }
            const int t = 16 * ti + (lane & 15);
            const float at = SC[t], mt = SC[128 + t];
            float o[4];
#pragma unroll
            for (int e = 0; e < 4; ++e) { const int s = 16 * si + 4 * (lane >> 4) + e;
                o[e] = (si <= ti && s <= t) ? acc[e] * __expf(at - SC[s] + SC[64 + s] - mt) : 0.f; }
            u32x2 ov; ov.x = pack2(o[0], o[1]); ov.y = pack2(o[2], o[3]);
            *(u32x2*)(So + t * 64 + 16 * si + 4 * (lane >> 4)) = ov;
        }
        __syncthreads();
    }
}
DI void mlstm_scan_phase(const Ctx& c0, bf16_t* big, const bf16_t* CA, const float* scal, const bf16_t* Sg, const float* __restrict__ wq, const float* __restrict__ wk, const float* __restrict__ wv) {
    const Ctx c = mk(c0);
    constexpr int PS = 144, PV = 80, PT = 136;
    constexpr unsigned PART_O = 0, SS_O = 69632, VA_O = SS_O + 64 * PS, VHT_O = VA_O + 64 * PV, SCL_O = VHT_O + 32 * PT, QT_O = SCL_O + 2048;
    LAS float* PART = (LAS float*)(c.lds + PART_O);
    LAS float* SCL = (LAS float*)(c.lds + SCL_O);
    const int lane = c.lane, w = c.wave, tid = c.tid, g4 = lane >> 4, l15 = lane & 15;
    for (int wi_ = c.bid; wi_ < 256; wi_ += c.nb) {
        const int bh = wi_ & 7, sl = wi_ >> 3, b = bh >> 2, h = bh & 3;
        const int vcol = h * 512 + sl * 16;
        bf16x8 mfr[4];
        {
            float4 wkr[4][4], wqr[4];
#pragma unroll
            for (int i4 = 0; i4 < 4; ++i4) { const int d = 64 * w + 16 * i4 + l15, nbk = (h * 512 + d) >> 2;
#pragma unroll
                for (int cc = 0; cc < 4; ++cc) wkr[i4][cc] = *(const float4*)(wk + nbk * 16 + cc * 4);
                wqr[i4] = *(const float4*)(wq + nbk * 16 + (d & 3) * 4); }
#pragma unroll
            for (int i4 = 0; i4 < 4; ++i4) {
                const int d = 64 * w + 16 * i4 + l15, cbase = 64 * w + 32 * (i4 >> 1);
                float m4[4];
#pragma unroll
                for (int cc = 0; cc < 4; ++cc) m4[cc] = 0.04419417382415922f * (wkr[i4][cc].x * wqr[i4].x + wkr[i4][cc].y * wqr[i4].y + wkr[i4][cc].z * wqr[i4].z + wkr[i4][cc].w * wqr[i4].w);
#pragma unroll
                for (int jj = 0; jj < 8; ++jj) {
                    const int cch = cbase + 16 * (jj >> 2) + 4 * g4 + (jj & 3);
                    mfr[i4][jj] = (short)f2bf(((cch >> 2) == (d >> 2)) ? m4[jj & 3] : 0.f);
                }
            }
        }
        LAS float* WVB = SCL + 448;
        if (tid < 64) WVB[tid] = wv[(vcol >> 2) * 16 + tid];
        __syncthreads();
        f32x4 accC[4][2];
#pragma unroll
        for (int i = 0; i < 4; ++i) { accC[i][0] = (f32x4){0.f, 0.f, 0.f, 0.f}; accC[i][1] = (f32x4){0.f, 0.f, 0.f, 0.f}; }
        float m_st = -INFINITY;
        u32x4 raw[8]; u32x4 sraw; u32x2 xraw = (u32x2){0u, 0u}; float sa = 0.f, sli = 0.f, sml = 0.f, sgm, sal;
        const int vs = tid >> 2;
#define MLSTM_PREFETCH(CH) do { const int it_ = bh * 128 + (CH); const int r0_ = b * SEQ + (CH) * 64; \
            _Pragma("unroll") for (int i = 0; i < 8; ++i) raw[i] = *(const u32x4*)(CA + (size_t)(r0_ + w + 8 * i) * 2048 + h * 512 + lane * 8); \
            sraw = *(const u32x4*)(Sg + (size_t)it_ * 4096 + tid * 8); \
            const float* sp_ = scal + (size_t)it_ * 256; \
            if (tid < 256) { xraw = *(const u32x2*)(big + (size_t)(r0_ + vs) * 4096 + vcol + 4 * (tid & 3)); sa = sp_[vs]; sli = sp_[64 + vs]; } \
            else if (tid < 320) { sa = sp_[tid - 256]; sml = sp_[128 + tid - 256]; } \
            sgm = sp_[192]; sal = sp_[193]; } while (0)
        unsigned hpend[4] = {0u, 0u, 0u, 0u};
        MLSTM_PREFETCH(0);
        for (int ch = 0; ch < 128; ++ch) {
            const int r0 = b * SEQ + ch * 64;
            LAS float* SC = SCL + (ch & 1) * 192;
            const float m_new = fmaxf(sal + m_st, sgm);
            const float dec = __expf(sal + m_st - m_new);
#pragma unroll
            for (int i = 0; i < 8; ++i) *(LAS u32x4*)(c.lds + QT_O + (w + 8 * i) * 1040 + lane * 16) = raw[i];
            *(LAS u32x4*)(c.lds + SS_O + (tid >> 3) * PS + (tid & 7) * 16) = sraw;
            if (tid < 256) {
                const float x[4] = {lo_f(xraw.x), hi_f(xraw.x), lo_f(xraw.y), hi_f(xraw.y)};
                float v[4];
                const int nb = tid & 3;
#pragma unroll
                for (int e = 0; e < 4; ++e) v[e] = x[0] * WVB[nb * 16 + e] + x[1] * WVB[nb * 16 + 4 + e] + x[2] * WVB[nb * 16 + 8 + e] + x[3] * WVB[nb * 16 + 12 + e];
                const float ws_ = __expf(sal - sa + sli - m_new);
                *(LAS u32x2*)(c.lds + VA_O + vs * PV + nb * 8) = (u32x2){pack2(v[0], v[1]), pack2(v[2], v[3])};
                *(LAS u32x2*)(c.lds + VA_O + vs * PV + 32 + nb * 8) = (u32x2){nb == 0 ? 0x3F80u : 0u, 0u};
#pragma unroll
                for (int e = 0; e < 4; ++e) {
                    *(LAS bf16_t*)(c.lds + VHT_O + (4 * nb + e) * PT + vs * 2) = (bf16_t)f2bf(v[e] * ws_);
                    *(LAS bf16_t*)(c.lds + VHT_O + (16 + 4 * nb + e) * PT + vs * 2) = (bf16_t)((nb == 0 && e == 0) ? f2bf(ws_) : 0u);
                }
            } else if (tid < 320) {
                const int t = tid - 256;
                const float mt = fmaxf(sml, sa + m_st);
                SC[t] = __expf(sml - mt); SC[64 + t] = __expf(sa + m_st - mt); SC[128 + t] = __expf(-mt);
            }
            LDS_BAR();
            if (ch + 1 < 128) MLSTM_PREFETCH(ch + 1);
            if (ch > 0 && (w & 1) == 0) {
#pragma unroll
                for (int e = 0; e < 4; ++e) big[(size_t)(r0 - 64 + 16 * (w >> 1) + 4 * g4 + e) * 4096 + vcol + l15] = (bf16_t)hpend[e];
            }
            u32x4 xa[4][2];
#pragma unroll
            for (int tt = 0; tt < 4; ++tt)
#pragma unroll
                for (int kk = 0; kk < 2; ++kk) {
                    const unsigned qo = QT_O + (16 * tt + l15) * 1040 + (64 * w + 32 * kk + 4 * g4) * 2;
                    const u32x2 lo_ = *(const LAS u32x2*)(c.lds + qo), hi_ = *(const LAS u32x2*)(c.lds + qo + 32);
                    xa[tt][kk] = (u32x4){lo_.x, lo_.y, hi_.x, hi_.y};
                }
            {
                f32x4 pacc[4][2];
#pragma unroll
                for (int tt = 0; tt < 4; ++tt) { pacc[tt][0] = (f32x4){0.f, 0.f, 0.f, 0.f}; pacc[tt][1] = (f32x4){0.f, 0.f, 0.f, 0.f}; }
#pragma unroll
                for (int kk = 0; kk < 2; ++kk) {
                    bf16x8 y[2];
#pragma unroll
                    for (int nt = 0; nt < 2; ++nt) {
                        u32x4 pk = (u32x4){pack2(accC[2 * kk][nt][0], accC[2 * kk][nt][1]), pack2(accC[2 * kk][nt][2], accC[2 * kk][nt][3]),
                                           pack2(accC[2 * kk + 1][nt][0], accC[2 * kk + 1][nt][1]), pack2(accC[2 * kk + 1][nt][2], accC[2 * kk + 1][nt][3])};
                        y[nt] = *(bf16x8*)&pk;
                    }
#pragma unroll
                    for (int tt = 0; tt < 4; ++tt) { const bf16x8 x = *(bf16x8*)&xa[tt][kk];
                        pacc[tt][0] = mfma16(x, y[0], pacc[tt][0]); pacc[tt][1] = mfma16(x, y[1], pacc[tt][1]); }
                }
#pragma unroll
                for (int tt = 0; tt < 4; ++tt)
#pragma unroll
                    for (int nt = 0; nt < 2; ++nt) *(LAS f32x4*)(PART + (w * 32 + 16 * nt + l15) * 68 + 16 * tt + 4 * g4) = pacc[tt][nt];
            }
            const int itt = w >> 1, intt = w & 1;
            f32x4 a2 = (f32x4){0.f, 0.f, 0.f, 0.f}, a3 = (f32x4){0.f, 0.f, 0.f, 0.f};
            if (intt == 0) {
                for (int s0 = 0; s0 <= 16 * itt + 15; s0 += 32) {
                    const bf16x8 xs = row_load(c.lds, SS_O, PS, 16 * itt, s0, lane);
                    a2 = mfma16(xs, tr_load(c.ldsb + VA_O, PV, s0, 0, lane), a2);
                    a3 = mfma16(xs, tr_load(c.ldsb + VA_O, PV, s0, 16, lane), a3);
                }
            }
            {
                bf16x8 yv[2][2];
#pragma unroll
                for (int k2 = 0; k2 < 2; ++k2)
#pragma unroll
                    for (int nt = 0; nt < 2; ++nt) {
                        const unsigned vo = VHT_O + (16 * nt + l15) * PT + (32 * k2 + 4 * g4) * 2;
                        const u32x2 lo_ = *(const LAS u32x2*)(c.lds + vo), hi_ = *(const LAS u32x2*)(c.lds + vo + 32);
                        u32x4 pk = (u32x4){lo_.x, lo_.y, hi_.x, hi_.y}; yv[k2][nt] = *(bf16x8*)&pk;
                    }
#pragma unroll
                for (int i4 = 0; i4 < 4; ++i4) {
                    accC[i4][0] = accC[i4][0] * dec; accC[i4][1] = accC[i4][1] * dec;
#pragma unroll
                    for (int k2 = 0; k2 < 2; ++k2) {
                        const f32x4 z = (f32x4){0.f, 0.f, 0.f, 0.f};
                        const f32x4 k0 = mfma16(*(bf16x8*)&xa[2 * k2][i4 >> 1], mfr[i4], z), k1 = mfma16(*(bf16x8*)&xa[2 * k2 + 1][i4 >> 1], mfr[i4], z);
                        u32x4 pk = (u32x4){pack2(k0[0], k0[1]), pack2(k0[2], k0[3]), pack2(k1[0], k1[1]), pack2(k1[2], k1[3])};
                        const bf16x8 kf = *(bf16x8*)&pk;
                        accC[i4][0] = mfma16(kf, yv[k2][0], accC[i4][0]); accC[i4][1] = mfma16(kf, yv[k2][1], accC[i4][1]);
                    }
                }
            }
            LDS_BAR();
            if (intt == 0) {
                f32x4 isum = (f32x4){0.f, 0.f, 0.f, 0.f}, dsum = (f32x4){0.f, 0.f, 0.f, 0.f};
#pragma unroll
                for (int ww = 0; ww < 8; ++ww) {
                    isum = isum + *(const LAS f32x4*)(PART + (ww * 32 + l15) * 68 + 16 * itt + 4 * g4);
                    dsum = dsum + *(const LAS f32x4*)(PART + (ww * 32 + 16) * 68 + 16 * itt + 4 * g4);
                }
#pragma unroll
                for (int e = 0; e < 4; ++e) {
                    const int t = 16 * itt + 4 * g4 + e;
                    const float a3e = __shfl(a3[e], lane & 48, 64);
                    const float den = fmaxf(fabsf(SC[t] * a3e + SC[64 + t] * dsum[e]), SC[128 + t]);
                    const float num = SC[t] * a2[e] + SC[64 + t] * isum[e];
                    hpend[e] = f2bf(num * __builtin_amdgcn_rcpf(den));
                }
            }
            m_st = m_new;
        }
        if ((w & 1) == 0) {
#pragma unroll
            for (int e = 0; e < 4; ++e) big[(size_t)(b * SEQ + 127 * 64 + 16 * (w >> 1) + 4 * g4 + e) * 4096 + vcol + l15] = (bf16_t)hpend[e];
        }
        __syncthreads();
#undef MLSTM_PREFETCH
    }
}
DI void mlstm_norm_phase(const Ctx& c0, const bf16_t* big, bf16_t* CA, const float* __restrict__ norm_g, const float* __restrict__ skip) {
    const Ctx c = mk(c0);
    for (int p0 = (c.bid * 8 + c.wave) * 4; p0 < T * 4; p0 += c.nb * 8 * 4) {
        const int row = p0 >> 2;
        u32x4 hr[4], zr[4], cr[4]; float4 gq[4][2], kq[4][2];
#pragma unroll
        for (int h = 0; h < 4; ++h) { const int col = h * 512 + 8 * c.lane;
            hr[h] = *(const u32x4*)(big + (size_t)row * 4096 + col); zr[h] = *(const u32x4*)(big + (size_t)row * 4096 + 2048 + col); cr[h] = *(const u32x4*)(CA + (size_t)row * 2048 + col);
            gq[h][0] = *(const float4*)(norm_g + col); gq[h][1] = *(const float4*)(norm_g + col + 4); kq[h][0] = *(const float4*)(skip + col); kq[h][1] = *(const float4*)(skip + col + 4); }
#pragma unroll
        for (int h = 0; h < 4; ++h) {
            const int col = h * 512 + 8 * c.lane;
            float x[8] = {lo_f(hr[h].x), hi_f(hr[h].x), lo_f(hr[h].y), hi_f(hr[h].y), lo_f(hr[h].z), hi_f(hr[h].z), lo_f(hr[h].w), hi_f(hr[h].w)};
            const float z[8] = {lo_f(zr[h].x), hi_f(zr[h].x), lo_f(zr[h].y), hi_f(zr[h].y), lo_f(zr[h].z), hi_f(zr[h].z), lo_f(zr[h].w), hi_f(zr[h].w)};
            const float ca[8] = {lo_f(cr[h].x), hi_f(cr[h].x), lo_f(cr[h].y), hi_f(cr[h].y), lo_f(cr[h].z), hi_f(cr[h].z), lo_f(cr[h].w), hi_f(cr[h].w)};
            float sm = 0.f;
#pragma unroll
            for (int i = 0; i < 8; ++i) sm += x[i];
            const float mean = wave_sum(sm) * (1.0f / 512.f);
            float q = 0.f;
#pragma unroll
            for (int i = 0; i < 8; ++i) { x[i] -= mean; q += x[i] * x[i]; }
            const float rstd = rsqrtf(wave_sum(q) * (1.0f / 512.f) + 1e-6f);
            const float4 g0 = gq[h][0], g1 = gq[h][1], k0 = kq[h][0], k1 = kq[h][1];
            const float gg[8] = {g0.x, g0.y, g0.z, g0.w, g1.x, g1.y, g1.z, g1.w}, sk[8] = {k0.x, k0.y, k0.z, k0.w, k1.x, k1.y, k1.z, k1.w};
            float o[8];
#pragma unroll
            for (int i = 0; i < 8; ++i) o[i] = (x[i] * rstd * gg[i] + sk[i] * ca[i]) * siluf_(z[i]);
            *(u32x4*)(CA + (size_t)row * 2048 + col) = (u32x4){pack2(o[0], o[1]), pack2(o[2], o[3]), pack2(o[4], o[5]), pack2(o[6], o[7])};
        }
    }
}

#ifndef PHSEL
#define PHSEL -1
#endif
#ifndef GSEL
#define GSEL -1
#endif
__global__ void __launch_bounds__(NTHR, 2) trunk_fwd(Args args) {
    extern __shared__ __attribute__((aligned(16))) unsigned char shm[];
    cg::grid_group grid = cg::this_grid();
    Ctx c;
    c.lds = (LAS unsigned char*)shm; c.ldsb = (unsigned)(uintptr_t)c.lds;
    c.tid = threadIdx.x; c.lane = c.tid & 63; c.wave = __builtin_amdgcn_readfirstlane(c.tid >> 6); c.bid = blockIdx.x; c.nb = gridDim.x;
    unsigned char* ws = args.ws;
    if (c.tid < 4) ((LAS unsigned*)(c.lds + LDS_BARST))[c.tid] = 0u;
    __syncthreads();
    const XcdBarrier xbar = xcd_barrier_post((unsigned*)(ws + WS_BAR), (volatile LAS unsigned*)(c.lds + LDS_BARST));
    bf16_t* Win = (bf16_t*)(ws + WS_WIN); bf16_t* Wout = (bf16_t*)(ws + WS_WOUT); bf16_t* W1 = (bf16_t*)(ws + WS_W1); bf16_t* W2 = (bf16_t*)(ws + WS_W2);
    bf16_t* HN = (bf16_t*)(ws + WS_HN); bf16_t* BIG = (bf16_t*)(ws + WS_BIG); bf16_t* CA = (bf16_t*)(ws + WS_CA);
    float* gates = (float*)(ws + WS_GATES); float* scal = (float*)(ws + WS_SCAL); float* dec = (float*)(ws + WS_DEC); float* stats = (float*)(ws + WS_STATS);
    bf16_t* SMAT = Win;
    float* H = args.out;
    const float* const* in = args.in;

    float* ssqA = (float*)(ws + WS_SSQA); float* ssqB = (float*)(ws + WS_SSQB);
#ifdef PROBE_L
    for (int pass = 0; pass < 2; ++pass)
#endif
    for (int layer = 0; layer < 4; ++layer) {
        const int kind = layer % 3, j = layer / 3;
        const int nmid = (kind == 0) ? 1 : (kind == 1 ? 3 : 4);
        const int nsteps = nmid + 5;
        for (int st = (layer == 0 ? 0 : 1); st < nsteps; ++st) {
#ifdef PROBE_L
            if (pass == 0 && (layer > PROBE_L || (layer == PROBE_L && st >= PROBE_S))) break;
#endif
            const int gsel = (st == 1) ? 0 : (st == nmid + 2) ? 1 : (st == nmid + 3) ? 2 : (st == nmid + 4) ? 3 : -1;
            if (gsel >= 0) {
                const bf16_t* A; const bf16_t* Bt; int lda, N, K, mode; const float* sin_ = ssqA; float* sout = ssqA;
                if (gsel == 0) { A = HN; lda = 1024; Bt = Win; N = 4096; K = 1024; mode = (kind == 0) ? 1 : 0; sin_ = ssqA; }
                else if (gsel == 1) { Bt = Wout; N = 1024; mode = 3; sout = ssqB;
                    if (kind == 0) { A = BIG; lda = 4096; K = 2048; } else if (kind == 1) { A = BIG + 3072; lda = 4096; K = 1024; } else { A = CA; lda = 2048; K = 2048; } }
                else if (gsel == 2) { A = HN; lda = 1024; Bt = W1; N = 4096; K = 1024; mode = 2; sin_ = ssqB; }
                else { A = BIG; lda = 4096; Bt = W2; N = 1024; K = 4096; mode = 3; sout = ssqA; }
                if (PHSEL < 0 || PHSEL == 2) run_gemm(c, A, lda, Bt, N, K, mode, BIG, HN, sin_, sout, (float*)CA);
                if (PHSEL < 0 || PHSEL == 0) {
                    if (gsel == 3 && layer < 3) {
                        const int nl = layer + 1, nk = nl % 3, nj = nl / 3;
                        const float* win = (nk == 0) ? in[7] + (size_t)nj * 1024 * 4096 : (nk == 1 ? in[13] : in[16]);
                        const float* wout = (nk == 0) ? in[12] + (size_t)nj * 2048 * 1024 : (nk == 1 ? in[15] : in[26]);
                        convert_wT(c, win, Win, 1024, 4096, in[1] + nl * 1024);
                        convert_wT(c, wout, Wout, nk == 1 ? 1024 : 2048, 1024, nullptr);
                        convert_wT(c, in[4] + (size_t)nl * 1024 * 4096, W1, 1024, 4096, in[2] + nl * 1024);
                    }
                    if (gsel == 0 && layer > 0) convert_wT(c, in[5] + (size_t)layer * 4096 * 1024, W2, 4096, 1024, nullptr);
                }
            } else if (st == 0) {
                const float* win = (kind == 0) ? in[7] + (size_t)j * 1024 * 4096 : (kind == 1 ? in[13] : in[16]);
                const float* wout = (kind == 0) ? in[12] + (size_t)j * 2048 * 1024 : (kind == 1 ? in[15] : in[26]);
                if (PHSEL < 0 || PHSEL == 0) {
                    convert_wT(c, win, Win, 1024, 4096, in[1] + layer * 1024);
                    convert_wT(c, wout, Wout, kind == 1 ? 1024 : 2048, 1024, nullptr);
                    convert_wT(c, in[4] + (size_t)layer * 1024 * 4096, W1, 1024, 4096, in[2] + layer * 1024);
                    convert_wT(c, in[5] + (size_t)layer * 4096 * 1024, W2, 4096, 1024, nullptr);
                }
                if (layer == 0) { if (PHSEL < 0 || PHSEL == 1) prologue_phase(c, in[0], HN, ssqA); }
            } else {
                const int m = st - 2;
                if (kind == 0) {
                    { if (PHSEL < 0 || PHSEL == 4) gmlp_spatial_phase(c, BIG, (const float*)CA, in[10] + (size_t)j * 16 * 128 * 128, in[11] + (size_t)j * 16 * 128, in[8] + (size_t)j * 2048, in[9] + (size_t)j * 2048); }
                } else if (kind == 1) {
                    if (m == 0) { if (PHSEL < 0 || PHSEL == 5) hgrn_local_phase(c, BIG, CA, dec, in[6], layer); }
                    else if (m == 1) { if (PHSEL < 0 || PHSEL == 6) hgrn_scan_phase(c, CA, dec); }
                    else { if (PHSEL < 0 || PHSEL == 7) hgrn_out_phase(c, BIG, CA, in[14]); }
                } else {
                    if (m == 0) { if (PHSEL < 0 || PHSEL == 8) mlstm_conv_phase(c, BIG, CA, gates, in[17], in[18], in[19], in[20], in[21], in[22], in[23]); }
                    else if (m == 1) { if (PHSEL < 0 || PHSEL == 9) mlstm_smat_phase(c, CA, gates, scal, SMAT, in[19], in[20]); }
                    else if (m == 2) { if (PHSEL < 0 || PHSEL == 10) mlstm_scan_phase(c, BIG, CA, scal, SMAT, in[19], in[20], in[21]); }
                    else { if (PHSEL < 0 || PHSEL == 11) mlstm_norm_phase(c, BIG, CA, in[25], in[24]); }
                }
            }
            if (args.use_cg) grid.sync();
            else xcd_barrier(xbar);
            if (layer == 0 && st == 0) {
                if (c.tid < 64) {
                    unsigned* bw = (unsigned*)(ws + WS_BAR);
                    const unsigned cnt = (c.tid < 16) ? xb_ld(&bw[XB_XCNT(c.tid)]) : 0u;
                    const bool good = (c.tid >= 16) || (cnt == (c.tid < 8 ? (unsigned)c.nb / 8u : 0u));
                    const bool ok = ((c.nb % 8) == 0) && (__ballot(good) == ~0ull);
                    volatile LAS unsigned* stw = (volatile LAS unsigned*)(c.lds + LDS_BARST);
                    if (c.tid == 0) stw[3] = ok ? stw[2] * 8u + xbar.x : (unsigned)blockIdx.x;
                }
                __syncthreads();
                c.bid = __builtin_amdgcn_readfirstlane((int)((volatile LAS unsigned*)(c.lds + LDS_BARST))[3]);
            }
        }
    }
    if (PHSEL < 0 || PHSEL == 12) final_norm_phase(c, HN, H, in[3], ssqA);
}

extern "C" void kernel_launch(void* const* d_in, const int* in_sizes, int n_in, void* d_out, int out_size, void* d_ws, size_t ws_size, hipStream_t stream) {
    static int grid = 0;
    if (grid == 0) {
        if (n_in != 27 || out_size != T * DM || ws_size < WS_END) { fprintf(stderr, "kernel_launch: unexpected shapes (n_in %d out %d ws %zu)\n", n_in, out_size, ws_size); grid = -1; return; }
        int dev = 0, cus = 0, per_cu = 0;
        hipGetDevice(&dev);
        hipDeviceGetAttribute(&cus, hipDeviceAttributeMultiprocessorCount, dev);
        if (hipFuncSetAttribute((const void*)trunk_fwd, hipFuncAttributeMaxDynamicSharedMemorySize, LDS_BYTES) != hipSuccess) { fprintf(stderr, "kernel_launch: hipFuncSetAttribute failed\n"); grid = -1; return; }
        if (hipOccupancyMaxActiveBlocksPerMultiprocessor(&per_cu, (const void*)trunk_fwd, NTHR, LDS_BYTES) != hipSuccess || per_cu < 1) { fprintf(stderr, "kernel_launch: occupancy query failed (%d)\n", per_cu); (void)hipGetLastError(); per_cu = 1; }
        grid = cus * 1;
        fprintf(stderr, "kernel_launch: grid %d (cus %d, per_cu %d)\n", grid, cus, per_cu);
    }
    if (grid < 0) return;
    if (hipMemsetAsync((char*)d_ws + WS_BAR, 0, XCD_BAR_WORDS * sizeof(unsigned), stream) != hipSuccess) { fprintf(stderr, "kernel_launch: memset of the barrier words failed\n"); return; }
    Args a{};
    for (int i = 0; i < 27; ++i) a.in[i] = (const float*)d_in[i];
    a.out = (float*)d_out; a.ws = (unsigned char*)d_ws; a.use_cg = 0; a.pad = 0;
    void* params[] = {&a};
    hipError_t e = hipLaunchCooperativeKernel((const void*)trunk_fwd, dim3(grid), dim3(NTHR), params, LDS_BYTES, stream);
    if (e != hipSuccess) fprintf(stderr, "kernel_launch: cooperative launch failed: %s\n", hipGetErrorString(e));
}
```
